# Optimizing an MI355X kernel written in HIP

```python
import jax, jax.numpy as jnp
from jax import lax
import numpy as np

D_MODEL = 1024
BATCH = 8
SEQ = 2048
DEPTH = 4

N_EVEN = (DEPTH + 1) // 2
N_ODD = DEPTH // 2

N_Q_HEADS = 8
N_KV_HEADS = 2
HEAD_DIM = 64
Q_GROUP = N_Q_HEADS // N_KV_HEADS
WINDOW = 128
ATTN_BLOCK = 128
ALIBI_MAX = 8.0
CONV_WIDTH_B = D_MODEL // 2
CONV_GROUPS_B = 8
CONV_K_B = 3
Q_DIM = N_Q_HEADS * HEAD_DIM
KV_DIM = N_KV_HEADS * HEAD_DIM
EVEN_IN = Q_DIM + 2 * KV_DIM + 3 * CONV_WIDTH_B
EVEN_MIX = Q_DIM + CONV_WIDTH_B
EVEN_SPLITS = (Q_DIM, Q_DIM + KV_DIM, Q_DIM + 2 * KV_DIM, Q_DIM + 2 * KV_DIM + CONV_WIDTH_B, Q_DIM + 2 * KV_DIM + 2 * CONV_WIDTH_B)
LRU_WIDTH = D_MODEL
LRU_HEADS = 8
LRU_HEAD_DIM = LRU_WIDTH // LRU_HEADS
CONV_K_C = 4
LRU_C = 8.0
D_FF = (D_MODEL * 7) // 2
N_EXPERTS = 8
TOP_K = 2
MOE_BLOCK = 128
NORM_EPS = 1e-6
NEG_INF = -1e30

kernel_name = 'hybrid_swa_shortconv_rglru_moe'


def rms_norm(x, g):
    xf = x.astype(jnp.float32)
    y = xf * lax.rsqrt(jnp.mean(xf * xf, axis=-1, keepdims=True) + NORM_EPS)
    return (y * g.astype(jnp.float32)).astype(x.dtype)


def causal_depthwise_conv(x, w):
    K = w.shape[0]
    S = x.shape[1]
    xp = jnp.pad(x, ((0, 0), (K - 1, 0), (0, 0)))
    return sum(xp[:, k:k + S] * w[k] for k in range(K))


def alibi_slopes():
    h = jnp.arange(1, N_Q_HEADS + 1, dtype=jnp.float32)
    return jnp.exp2(-ALIBI_MAX * h / N_Q_HEADS)


def sliding_window_attention(q, k, v, sinks):
    B, S = q.shape[0], q.shape[1]
    L = ATTN_BLOCK
    nb = S // L
    qb = q.reshape(B, nb, L, N_KV_HEADS, Q_GROUP, HEAD_DIM)

    def band(t):
        cur = t.reshape(B, nb, L, N_KV_HEADS, HEAD_DIM)
        prev = jnp.pad(cur, ((0, 0), (1, 0), (0, 0), (0, 0), (0, 0)))[:, :-1]
        return jnp.concatenate([prev, cur], axis=2)

    kb, vb = band(k), band(v)
    scores = jnp.einsum('bnqkgd,bnskd->bnkgqs', qb, kb, preferred_element_type=jnp.float32) * (HEAD_DIM ** -0.5)
    qi = jnp.arange(L)[:, None]
    sj = jnp.arange(2 * L)[None, :]
    diff = L + qi - sj
    s_abs = (jnp.arange(nb)[:, None] - 1) * L + jnp.arange(2 * L)[None, :]
    valid = (diff >= 0)[None] & (diff < WINDOW)[None] & (s_abs >= 0)[:, None, :]
    slopes = alibi_slopes().reshape(N_KV_HEADS, Q_GROUP)
    bias = -slopes[:, :, None, None] * diff.astype(jnp.float32)
    scores = jnp.where(valid[None, :, None, None], scores + bias, NEG_INF)
    sink = jnp.broadcast_to(sinks.astype(jnp.float32).reshape(N_KV_HEADS, Q_GROUP)[None, None, :, :, None, None], scores.shape[:-1] + (1,))
    probs = jax.nn.softmax(jnp.concatenate([scores, sink], axis=-1), axis=-1)[..., :-1]
    out = jnp.einsum('bnkgqs,bnskd->bnqkgd', probs.astype(v.dtype), vb)
    return out.reshape(B, S, Q_DIM)


def attn_conv_mixer(h, w_in, q_gain, k_gain, sinks, conv_w, w_out):
    B, S, _ = h.shape
    q, k, v, gate_b, gate_c, u = jnp.split(h @ w_in, EVEN_SPLITS, axis=-1)
    q = rms_norm(q.reshape(B, S, N_Q_HEADS, HEAD_DIM), q_gain)
    k = rms_norm(k.reshape(B, S, N_KV_HEADS, HEAD_DIM), k_gain)
    v = v.reshape(B, S, N_KV_HEADS, HEAD_DIM)
    attn = sliding_window_attention(q, k, v, sinks)
    conv = gate_b * causal_depthwise_conv(gate_c * u, conv_w)
    return jnp.concatenate([attn, conv], axis=-1) @ w_out


def recurrent_mixer(h, w_in, conv_w, conv_b, ga_w, ga_b, gx_w, gx_b, lam, w_out):
    B, S, _ = h.shape
    y_branch, x_branch = jnp.split(h @ w_in, 2, axis=-1)
    y_branch = jax.nn.gelu(y_branch)
    xc = causal_depthwise_conv(x_branch, conv_w) + conv_b
    xh = xc.reshape(B, S, LRU_HEADS, LRU_HEAD_DIM)
    r = jax.nn.sigmoid(jnp.einsum('bshi,hij->bshj', xh, ga_w).reshape(B, S, LRU_WIDTH) + ga_b)
    i = jax.nn.sigmoid(jnp.einsum('bshi,hij->bshj', xh, gx_w).reshape(B, S, LRU_WIDTH) + gx_b)
    log_a = -LRU_C * r.astype(jnp.float32) * jax.nn.softplus(-lam.astype(jnp.float32))
    a = jnp.exp(log_a)
    mult = jnp.sqrt(jnp.maximum(-jnp.expm1(2.0 * log_a), 0.0))
    mult = jnp.where(jnp.arange(S)[None, :, None] == 0, 1.0, mult)
    b = mult * (i * xc).astype(jnp.float32)

    def combine(c1, c2):
        a1, b1 = c1
        a2, b2 = c2
        return a1 * a2, a2 * b1 + b2

    _, hs = lax.associative_scan(combine, (a, b), axis=1)
    return (y_branch * hs.astype(h.dtype)) @ w_out


def swiglu(h, w_gate, w_up, w_down):
    return (jax.nn.silu(h @ w_gate) * (h @ w_up)) @ w_down


def moe_swiglu(h, w_router, w_gate, w_up, w_down):
    B, S, D = h.shape
    T = B * S
    xf = h.reshape(T, D)
    logits = (xf @ w_router).astype(jnp.float32)
    top_logits, top_idx = lax.top_k(logits, TOP_K)
    gates = jax.nn.softmax(top_logits, axis=-1)
    n_assign = T * TOP_K
    e_flat = top_idx.reshape(-1).astype(jnp.int32)
    tok_flat = jnp.repeat(jnp.arange(T, dtype=jnp.int32), TOP_K)
    g_flat = gates.reshape(-1)
    order = jnp.argsort(e_flat)
    e_sorted = e_flat[order]
    counts = jnp.zeros((N_EXPERTS,), jnp.int32).at[e_flat].add(1)
    padded = (counts + MOE_BLOCK - 1) // MOE_BLOCK * MOE_BLOCK
    pad_end = jnp.cumsum(padded)
    pad_start = pad_end - padded
    start = jnp.cumsum(counts) - counts
    dest = pad_start[e_sorted] + jnp.arange(n_assign, dtype=jnp.int32) - start[e_sorted]
    n_rows = n_assign + N_EXPERTS * MOE_BLOCK
    n_blocks = n_rows // MOE_BLOCK
    row_tok = jnp.zeros((n_rows,), jnp.int32).at[dest].set(tok_flat[order])
    row_gate = jnp.zeros((n_rows,), jnp.float32).at[dest].set(g_flat[order])
    blk_start = jnp.arange(n_blocks, dtype=jnp.int32) * MOE_BLOCK
    blk_expert = jnp.minimum(jnp.searchsorted(pad_end, blk_start, side='right'), N_EXPERTS - 1)

    def expert_block(args):
        tok, e = args
        xb = xf[tok]
        hb = jax.nn.silu(xb @ w_gate[e]) * (xb @ w_up[e])
        return hb @ w_down[e]

    yb = lax.map(expert_block, (row_tok.reshape(n_blocks, MOE_BLOCK), blk_expert))
    y = yb.reshape(n_rows, D).astype(jnp.float32) * row_gate[:, None]
    out = jnp.zeros((T, D), jnp.float32).at[row_tok].add(y)
    return out.astype(h.dtype).reshape(B, S, D)


def setup_inputs(seed: int = 0) -> dict:
    key = jax.random.key(seed)
    ks = iter(jax.random.split(key, 32))
    f32 = jnp.float32
    res_scale = (2 * DEPTH) ** -0.5

    def nrm(shape, scale):
        return jax.random.normal(next(ks), shape, f32) * scale

    x = nrm((BATCH, SEQ, D_MODEL), 1.0)
    norm_mix = 1.0 + nrm((DEPTH, D_MODEL), 0.02)
    norm_ffn = 1.0 + nrm((DEPTH, D_MODEL), 0.02)
    hy_w_in = nrm((N_EVEN, D_MODEL, EVEN_IN), D_MODEL ** -0.5)
    hy_q_gain = 1.0 + nrm((N_EVEN, HEAD_DIM), 0.02)
    hy_k_gain = 1.0 + nrm((N_EVEN, HEAD_DIM), 0.02)
    hy_sinks = nrm((N_EVEN, N_Q_HEADS), 0.5)
    hy_conv_w = nrm((N_EVEN, CONV_K_B, CONV_WIDTH_B), CONV_K_B ** -0.5)
    hy_w_out = nrm((N_EVEN, EVEN_MIX, D_MODEL), EVEN_MIX ** -0.5 * res_scale)
    rg_w_in = nrm((N_ODD, D_MODEL, 2 * LRU_WIDTH), D_MODEL ** -0.5)
    rg_conv_w = nrm((N_ODD, CONV_K_C, LRU_WIDTH), CONV_K_C ** -0.5)
    rg_conv_b = nrm((N_ODD, LRU_WIDTH), 0.01)
    rg_gate_a_w = nrm((N_ODD, LRU_HEADS, LRU_HEAD_DIM, LRU_HEAD_DIM), LRU_HEAD_DIM ** -0.5)
    rg_gate_a_b = nrm((N_ODD, LRU_WIDTH), 0.01)
    rg_gate_x_w = nrm((N_ODD, LRU_HEADS, LRU_HEAD_DIM, LRU_HEAD_DIM), LRU_HEAD_DIM ** -0.5)
    rg_gate_x_b = nrm((N_ODD, LRU_WIDTH), 0.01)
    a_pow_c = jax.random.uniform(next(ks), (N_ODD, LRU_WIDTH), f32, minval=0.9, maxval=0.999)
    a0 = a_pow_c ** (1.0 / LRU_C)
    rg_lambda = jnp.log(a0) - jnp.log1p(-a0)
    rg_w_out = nrm((N_ODD, LRU_WIDTH, D_MODEL), LRU_WIDTH ** -0.5 * res_scale)
    ffn_w_gate = nrm((N_EVEN, D_MODEL, D_FF), D_MODEL ** -0.5)
    ffn_w_up = nrm((N_EVEN, D_MODEL, D_FF), D_MODEL ** -0.5)
    ffn_w_down = nrm((N_EVEN, D_FF, D_MODEL), D_FF ** -0.5 * res_scale)
    moe_router = nrm((N_ODD, D_MODEL, N_EXPERTS), D_MODEL ** -0.5)
    moe_w_gate = nrm((N_ODD, N_EXPERTS, D_MODEL, D_FF), D_MODEL ** -0.5)
    moe_w_up = nrm((N_ODD, N_EXPERTS, D_MODEL, D_FF), D_MODEL ** -0.5)
    moe_w_down = nrm((N_ODD, N_EXPERTS, D_FF, D_MODEL), D_FF ** -0.5 * res_scale)
    return {'x': x, 'norm_mix': norm_mix, 'norm_ffn': norm_ffn,
            'hy_w_in': hy_w_in, 'hy_q_gain': hy_q_gain, 'hy_k_gain': hy_k_gain, 'hy_sinks': hy_sinks,
            'hy_conv_w': hy_conv_w, 'hy_w_out': hy_w_out,
            'rg_w_in': rg_w_in, 'rg_conv_w': rg_conv_w, 'rg_conv_b': rg_conv_b,
            'rg_gate_a_w': rg_gate_a_w, 'rg_gate_a_b': rg_gate_a_b, 'rg_gate_x_w': rg_gate_x_w,
            'rg_gate_x_b': rg_gate_x_b, 'rg_lambda': rg_lambda, 'rg_w_out': rg_w_out,
            'ffn_w_gate': ffn_w_gate, 'ffn_w_up': ffn_w_up, 'ffn_w_down': ffn_w_down,
            'moe_router': moe_router, 'moe_w_gate': moe_w_gate, 'moe_w_up': moe_w_up, 'moe_w_down': moe_w_down}


def reference(x, norm_mix, norm_ffn, hy_w_in, hy_q_gain, hy_k_gain, hy_sinks, hy_conv_w, hy_w_out,
              rg_w_in, rg_conv_w, rg_conv_b, rg_gate_a_w, rg_gate_a_b, rg_gate_x_w, rg_gate_x_b, rg_lambda, rg_w_out,
              ffn_w_gate, ffn_w_up, ffn_w_down, moe_router, moe_w_gate, moe_w_up, moe_w_down):
    for layer in range(DEPTH):
        j = layer // 2
        h = rms_norm(x, norm_mix[layer])
        if layer % 2 == 0:
            x = x + attn_conv_mixer(h, hy_w_in[j], hy_q_gain[j], hy_k_gain[j], hy_sinks[j], hy_conv_w[j], hy_w_out[j])
            h = rms_norm(x, norm_ffn[layer])
            x = x + swiglu(h, ffn_w_gate[j], ffn_w_up[j], ffn_w_down[j])
        else:
            x = x + recurrent_mixer(h, rg_w_in[j], rg_conv_w[j], rg_conv_b[j], rg_gate_a_w[j], rg_gate_a_b[j],
                                    rg_gate_x_w[j], rg_gate_x_b[j], rg_lambda[j], rg_w_out[j])
            h = rms_norm(x, norm_ffn[layer])
            x = x + moe_swiglu(h, moe_router[j], moe_w_gate[j], moe_w_up[j], moe_w_down[j])
    return x
```

```cpp
#include <hip/hip_runtime.h>
#include <cstdio>
#include <cstdint>

#ifndef MK_PER_PHASE
#define MK_PER_PHASE 0
#endif

#ifndef PROBE_DUP
#define PROBE_DUP 0u
#endif
#define REP(k) _Pragma("unroll 1") for (int rep_ = 0; rep_ < (int)((PROBE_DUP >> (k)) & 1u) + 1; ++rep_)
#define LAS __attribute__((address_space(3)))
#define GAS __attribute__((address_space(1)))
typedef unsigned short bf16;
typedef short bf16x8 __attribute__((ext_vector_type(8)));
typedef float f32x4 __attribute__((ext_vector_type(4)));
typedef float f32x2 __attribute__((ext_vector_type(2)));
typedef unsigned u32x4 __attribute__((ext_vector_type(4)));
typedef unsigned u32x2 __attribute__((ext_vector_type(2)));
typedef int i32x4 __attribute__((ext_vector_type(4)));
typedef int i32x8 __attribute__((ext_vector_type(8)));

constexpr int D = 1024, BATCH = 8, SEQ = 2048, M = BATCH * SEQ;
constexpr int EIN = 2304, FF = 3584, NE = 8, ECAP = 16384;
constexpr int MAXROWS = 34816;
constexpr int NWAVES = 8, NTHR = 512;
constexpr float NORM_EPS = 1e-6f;
#define FFN_F8(j) ((j) == 1)
#define FFN_DN_F8(j) (true)
constexpr int WGU_SH = 5, WDN_SH = 7; constexpr float WGU_SCALE = (float)(1 << WGU_SH), WDN_SCALE = (float)(1 << WDN_SH);
constexpr int MOE_DEFER_R0 = 800;
constexpr int DSPL = 7, DTAILROW0 = 32768, DTAILROWS = 2304;
constexpr int SCH = 32, NSCH = SEQ / SCH;

constexpr size_t MiB = 1u << 20;
constexpr size_t WS_CTL = 0, CTL_ZERO_BYTES = 1 * MiB;
constexpr size_t WS_SELP = 1 * MiB;
constexpr size_t WS_GATE2 = WS_SELP + 128 * 1024;
constexpr size_t WS_CC = WS_SELP + 512 * 1024;
constexpr size_t WS_CSLOT = 2 * MiB;
constexpr size_t WS_ROWG = WS_CSLOT + 256 * 1024;
constexpr size_t WS_CARA = 836 * MiB;
constexpr size_t WS_CARH = 838 * MiB;
constexpr size_t WS_WINE = 5 * MiB;
constexpr size_t WS_WOUTE = 14 * MiB;
constexpr size_t WS_WINO = 18 * MiB;
constexpr size_t WS_WOUTO = 26 * MiB;
constexpr size_t WS_WG = 30 * MiB;
constexpr size_t WS_WGU = 31 * MiB;
constexpr size_t WS_WDN = 59 * MiB;
constexpr size_t WS_WGUM = 73 * MiB;
constexpr size_t WS_WDNM = 297 * MiB;
constexpr size_t WS_H = 409 * MiB;
constexpr size_t WS_U = 441 * MiB;
constexpr size_t WS_P = WS_U;
constexpr size_t WS_MIX = WS_U + 72 * MiB;
constexpr size_t WS_XC = WS_U + 104 * MiB;
constexpr size_t WS_GT = WS_U + 136 * MiB;
constexpr size_t WS_HID = WS_U;
constexpr size_t WS_YB = 705 * MiB;
constexpr size_t WS_PART = 773 * MiB;
constexpr size_t WS_HG = WS_YB;
constexpr size_t WS_PS = 841 * MiB;
constexpr size_t WS_X = 842 * MiB;
constexpr size_t WS_END = 874 * MiB;
static_assert(WS_PART + (size_t)DSPL * DTAILROWS * D * 4 <= WS_PS && WS_YB + (size_t)MAXROWS * D * 2 <= WS_PART && (size_t)MAXROWS * FF * 2 <= 264 * MiB && WS_GT + 64 * MiB <= WS_U + 264 * MiB && WS_U + 264 * MiB == WS_YB, "ws map");
constexpr int CW_BAR = 4096;
constexpr int CW_CNT = 16384;

constexpr int RING_BYTES = 131072;
constexpr int LDSCTL_OFF = RING_BYTES, MISC_OFF = LDSCTL_OFF + 320;
constexpr int LDS_BYTES = 147456;
constexpr int RS_OFF = LDSCTL_OFF + 4096;

#define RLX_AGENT __ATOMIC_RELAXED, __HIP_MEMORY_SCOPE_AGENT
#define LDS_WAIT() asm volatile("s_waitcnt lgkmcnt(0)" ::: "memory")
#define VM_WAIT() asm volatile("s_waitcnt vmcnt(0)" ::: "memory")
__device__ __forceinline__ unsigned cvt_pk_bf16(float lo, float hi) { unsigned r; asm volatile("v_cvt_pk_bf16_f32 %0, %1, %2" : "=v"(r) : "v"(lo), "v"(hi)); return r; }
__device__ __forceinline__ unsigned pk4_fp8(float a, float b, float c, float d) { int w = 0; w = __builtin_amdgcn_cvt_pk_fp8_f32(a, b, w, false); w = __builtin_amdgcn_cvt_pk_fp8_f32(c, d, w, true); return (unsigned)w; }
__device__ __forceinline__ float bflo(unsigned w) { return __uint_as_float(w << 16); }
__device__ __forceinline__ float bfhi(unsigned w) { return __uint_as_float(w & 0xffff0000u); }
__device__ __forceinline__ int lane_v() { int l; asm volatile("v_mbcnt_lo_u32_b32 %0, -1, 0\n\tv_mbcnt_hi_u32_b32 %0, -1, %0" : "=v"(l)); return l; }
__device__ __forceinline__ float shx(float v, int m) { return __int_as_float(__builtin_amdgcn_ds_bpermute((lane_v() ^ m) << 2, __float_as_int(v))); }
__device__ __forceinline__ int shup(int v, int o) { const int l = lane_v(); const int t = __builtin_amdgcn_ds_bpermute(((l - o) & 63) << 2, v); return (l >= o) ? t : v; }
__device__ __forceinline__ float wave_sum(float v) {
#pragma unroll
    for (int o = 1; o < 64; o <<= 1) v += shx(v, o);
    return v;
}
__device__ __forceinline__ int wv_laundered(int wv) { asm volatile("" : "+s"(wv)); return wv; }
__device__ __forceinline__ int tid_laundered(int wv) { int l; asm volatile("v_mbcnt_lo_u32_b32 %0, -1, 0\n\tv_mbcnt_hi_u32_b32 %0, -1, %0" : "=v"(l)); return wv * 64 + l; }
__device__ __forceinline__ float fast_rcp(float x) { return __builtin_amdgcn_rcpf(x); }
__device__ __forceinline__ float fast_exp(float x) { return __builtin_amdgcn_exp2f(x * 1.4426950408889634f); }
__device__ __forceinline__ float sigmoidf_(float x) { return fast_rcp(1.0f + fast_exp(-x)); }
__device__ __forceinline__ float gelu_tanh(float v) { const float u = 1.5957691216057308f * (v + 0.044715f * v * v * v); return v * sigmoidf_(u); }
__device__ __forceinline__ float siluf_(float v) { return v * sigmoidf_(v); }

#define XB_TMO      128
#define XB_XCNT(j)  (256  + 64 * (j))
#define XB_XSUB(j)  (1280 + 64 * (j))
#define XB_XGEN(j)  (2304 + 64 * (j))
#define XB_TOP      3328
#define XB_TOPGEN   3392
#define XCD_BAR_WORDS 3456
#define XB_SPIN_CAP (1u << 22)

__device__ __forceinline__ unsigned xb_ld(unsigned* p)              { return __hip_atomic_load(p, __ATOMIC_RELAXED, __HIP_MEMORY_SCOPE_AGENT); }
__device__ __forceinline__ unsigned xb_add(unsigned* p, unsigned v) { return __hip_atomic_fetch_add(p, v, __ATOMIC_RELAXED, __HIP_MEMORY_SCOPE_AGENT); }
__device__ __forceinline__ unsigned xb_xcc_id() { return (unsigned)__builtin_amdgcn_s_getreg((3 << 11) | 20) & 0xFu; }
#define XB_SPIN(cond, bar) do { unsigned _sp = 0; while (cond) { __builtin_amdgcn_s_sleep(1); \
    if ((++_sp & 255u) == 0u) { if (xb_ld(&(bar)[XB_TMO])) break; if (_sp > XB_SPIN_CAP) { atomicAdd(&(bar)[XB_TMO], 1u); break; } } } } while (0)

struct XcdBarrier { unsigned* bar; unsigned x; volatile LAS unsigned* st; };

__device__ __forceinline__ XcdBarrier xcd_barrier_post(unsigned* bar, volatile LAS unsigned* st, bool leader) {
    XcdBarrier b; b.bar = bar; b.x = xb_xcc_id(); b.st = st;
    if (leader) (void)xb_add(&bar[XB_XCNT(b.x)], 1u);
    return b;
}
__device__ __forceinline__ void xcd_barrier_complete(unsigned* bar, unsigned x, unsigned& nloc, unsigned& nx) {
    const unsigned G = gridDim.x * gridDim.y * gridDim.z;
    unsigned sum, cnt, mine, sp = 0u;
    for (;;) {
        sum = 0u; cnt = 0u; mine = 0u;
#pragma unroll
        for (unsigned j = 0; j < 16; ++j) { const unsigned c = xb_ld(&bar[XB_XCNT(j)]); sum += c; cnt += (c > 0u) ? 1u : 0u; mine = (j == x) ? c : mine; }
        if (sum == G) break;
        __builtin_amdgcn_s_sleep(1);
        if ((++sp & 255u) == 0u) { if (xb_ld(&bar[XB_TMO])) break; if (sp > XB_SPIN_CAP) { atomicAdd(&bar[XB_TMO], 1u); break; } }
    }
    nloc = mine > 0u ? mine : 1u; nx = cnt > 0u ? cnt : 1u;
}
__device__ __forceinline__ void xcd_barrier(const XcdBarrier& b, bool leader) {
    asm volatile("s_waitcnt vmcnt(0)" ::: "memory");
    __syncthreads();
    if (leader) {
        unsigned* bar = b.bar;
        __builtin_amdgcn_s_waitcnt(0);
        unsigned nloc = b.st[0], nx = b.st[1];
        if (nloc == 0u) { xcd_barrier_complete(bar, b.x, nloc, nx); b.st[0] = nloc; b.st[1] = nx; }
        const unsigned old = xb_add(&bar[XB_XSUB(b.x)], 1u);
        const unsigned gen = old / nloc;
        if (old + 1u == (gen + 1u) * nloc) {
            __builtin_amdgcn_fence(__ATOMIC_RELEASE, "agent");
            asm volatile("s_waitcnt vmcnt(0)" ::: "memory");
            const unsigned og = xb_add(&bar[XB_TOP], 1u);
            const unsigned tg = og / nx;
            if (og + 1u == (tg + 1u) * nx) xb_add(&bar[XB_TOPGEN], 1u);
            else XB_SPIN(xb_ld(&bar[XB_TOPGEN]) == tg, bar);
            __builtin_amdgcn_fence(__ATOMIC_ACQUIRE, "agent");
            xb_add(&bar[XB_XGEN(b.x)], 1u);
            asm volatile("s_waitcnt vmcnt(0)" ::: "memory");
        } else {
            __builtin_amdgcn_fence(__ATOMIC_ACQUIRE, "agent");
            XB_SPIN(xb_ld(&bar[XB_XGEN(b.x)]) == gen, bar);
            asm volatile("s_waitcnt vmcnt(0)" ::: "memory");
        }
    }
    __syncthreads();
}

namespace pg8 {
constexpr int BM = 256, BK = 64, HALF = 128, HTB = HALF * BK * 2, STAGE_BYTES = 8 * HTB, NXCD = 8, WGM = 8;
__host__ __device__ __forceinline__ int lds_byte(int r, int c) { const int st = (r >> 4) * 2 + (c >> 5), rr = r & 15, cc = c & 31, ob = rr * 64 + cc * 2; return st * 1024 + (ob ^ (((ob >> 9) & 1) << 5)); }
__host__ __device__ __forceinline__ void stage_rc(int b, int& R, int& C) { const int st = b / 1024, sb = b % 1024, swz = sb ^ (((sb >> 9) & 1) << 5); R = (st >> 1) * 16 + swz / 64; C = (st & 1) * 32 + (swz % 64) / 2; }
__host__ __device__ __forceinline__ int perm32(int rho) { const int n = rho >> 4, i = rho & 15; return 8 * (i >> 2) + 4 * n + (i & 3); }

struct Unit { int pm, pn, ks; };

struct StaticOrder {
    int nM, nN, nwg, G, c;
    const char* A; const char* B; size_t a_pm, a_pn, b_pn;
    __device__ __forceinline__ void init(int nM_, int nN_, int G_, int c_, const void* A_, size_t a_pm_, size_t a_pn_, const void* B_, size_t b_pn_) {
        nM = nM_; nN = nN_; nwg = nM * nN; G = G_; c = c_; A = (const char*)A_; B = (const char*)B_; a_pm = a_pm_; a_pn = a_pn_; b_pn = b_pn_; }
    __device__ __forceinline__ bool next(int i, Unit& u) const {
        const long L = (long)i * G + c; if (L >= nwg) return false;
        int wgid = (int)L; { const int q = nwg / NXCD, r = nwg % NXCD, xcd = wgid % NXCD, off = wgid / NXCD; wgid = (xcd < r ? xcd * (q + 1) : r * (q + 1) + (xcd - r) * q) + off; }
        const int nig = WGM * nN, gid = wgid / nig, fm = gid * WGM, gsz = (nM - fm) < WGM ? (nM - fm) : WGM;
        u.pm = __builtin_amdgcn_readfirstlane(fm + ((wgid % nig) % gsz)); u.pn = __builtin_amdgcn_readfirstlane((wgid % nig) / gsz); u.ks = -1; return true;
    }
    __device__ __forceinline__ const char* a_ptr(const Unit& u) const { return A + (size_t)u.pm * a_pm + (size_t)u.pn * a_pn; }
    __device__ __forceinline__ const char* b_ptr(const Unit& u) const { return B + (size_t)u.pn * b_pn; }
    __device__ __forceinline__ int unit_nt(const Unit&, int nt) const { return nt; }
};
struct GroupOrder {
    int nM, nN, nwg, G, c; int cum[8];
    const char* A; const char* B; size_t a_pm, b_pn, b_e;
    __device__ __forceinline__ bool next(int i, Unit& u) const {
        const long L = (long)i * G + c; if (L >= nwg) return false;
        int wgid = (int)L; { const int q = nwg / NXCD, r = nwg % NXCD, xcd = wgid % NXCD, off = wgid / NXCD; wgid = (xcd < r ? xcd * (q + 1) : r * (q + 1) + (xcd - r) * q) + off; }
        const int nig = WGM * nN, gid = wgid / nig, fm = gid * WGM, gsz = (nM - fm) < WGM ? (nM - fm) : WGM;
        u.pm = __builtin_amdgcn_readfirstlane(fm + ((wgid % nig) % gsz)); u.pn = __builtin_amdgcn_readfirstlane((wgid % nig) / gsz); u.ks = -1; return true;
    }
    __device__ __forceinline__ const char* a_ptr(const Unit& u) const { return A + (size_t)u.pm * a_pm; }
    __device__ __forceinline__ const char* b_ptr(const Unit& u) const {
        const int e = __builtin_amdgcn_readfirstlane((u.pm >= cum[0]) + (u.pm >= cum[1]) + (u.pm >= cum[2]) + (u.pm >= cum[3]) + (u.pm >= cum[4]) + (u.pm >= cum[5]) + (u.pm >= cum[6]));
        return B + (size_t)e * b_e + (size_t)u.pn * b_pn; }
    __device__ __forceinline__ int unit_nt(const Unit&, int nt) const { return nt; }
};
struct DownOrder {
    int NP, G, c, TU; bool split; int cum[8];
    const char* A; const char* B; size_t a_pm, b_pn, b_e;
    __device__ __forceinline__ bool next(int i, Unit& u) const {
        if (split) {
            if (i < 2) { const int x = c & 7, l = i * 32 + (c >> 3); u.pm = __builtin_amdgcn_readfirstlane(x + 8 * (l >> 2)); u.pn = __builtin_amdgcn_readfirstlane(l & 3); u.ks = -1; return true; }
            if (i == 2 && c < TU * DSPL) { const int j = c / DSPL; u.pm = __builtin_amdgcn_readfirstlane(128 + (j >> 2)); u.pn = __builtin_amdgcn_readfirstlane(j & 3); u.ks = __builtin_amdgcn_readfirstlane(c - DSPL * j); return true; }
            return false;
        }
        const long L = (long)i * G + c; if (L >= (long)NP * 4) return false;
        u.pm = __builtin_amdgcn_readfirstlane((int)(L >> 2)); u.pn = __builtin_amdgcn_readfirstlane((int)(L & 3)); u.ks = -1; return true;
    }
    __device__ __forceinline__ size_t koff(const Unit& u) const { return u.ks > 0 ? (size_t)u.ks * (FF / DSPL) : 0; }
    __device__ __forceinline__ const char* a_ptr(const Unit& u) const { return A + (size_t)u.pm * a_pm + koff(u); }
    __device__ __forceinline__ const char* b_ptr(const Unit& u) const {
        const int e = __builtin_amdgcn_readfirstlane((u.pm >= cum[0]) + (u.pm >= cum[1]) + (u.pm >= cum[2]) + (u.pm >= cum[3]) + (u.pm >= cum[4]) + (u.pm >= cum[5]) + (u.pm >= cum[6]));
        return B + (size_t)e * b_e + (size_t)u.pn * b_pn + koff(u); }
    __device__ __forceinline__ int unit_nt(const Unit& u, int nt) const { return u.ks >= 0 ? (FF / DSPL) / 128 : nt; }
};

typedef f32x4 Acc[2][2][4][2];
__device__ __forceinline__ const char* uni_ptr(const char* p) {
    const unsigned long long v = (unsigned long long)p; const unsigned lo = __builtin_amdgcn_readfirstlane((unsigned)v), hi = __builtin_amdgcn_readfirstlane((unsigned)(v >> 32));
    return (const char*)(((unsigned long long)hi << 32) | lo); }
template <int OFF, int LOFF>
__device__ __forceinline__ void glds16s(const char* sbase, unsigned voff, unsigned lds_base) {
    asm volatile("s_add_u32 m0, %2, %4\n\ts_nop 0\n\tglobal_load_lds_dwordx4 %0, %1 offset:%3" :: "v"(voff), "s"(sbase), "s"(lds_base), "n"(OFF), "n"(LOFF - OFF) : "memory", "scc");
}

template <class Epi> __device__ __forceinline__ constexpr int mxs_() { return 0x01010101 * (127 - Epi::MXSH); }
template <bool FP8, class Epi, class Sched>
__device__ __forceinline__ void gemm_phase(LAS unsigned char* lds, const int wv, const int ldaB, const int ldbB, const int KB, const Sched S, const Epi E) {
    const int wid = wv_laundered(wv), tid = tid_laundered(wid), lane = tid & 63, wr = wid >> 2, wc = wid & 3, fr = lane & 15, fq = lane >> 4;
    int nt = KB / 128; asm volatile("" : "+s"(nt));
    unsigned voffA[2], voffB[2];
#pragma unroll
    for (int i = 0; i < 2; ++i) { int R, C; stage_rc(tid * 16 + i * 8192, R, C); const int Rb = Epi::PERM ? ((R & ~31) + perm32(R & 31)) : R;
        voffA[i] = (unsigned)(R * ldaB + 2 * C); voffB[i] = (unsigned)(Rb * ldbB + 2 * C); }
    const size_t kstep = (size_t)(BK * 2);
    const size_t hstepA = (size_t)HALF * ldaB, hstepB = (size_t)HALF * ldbB;
    const unsigned ldsb = (unsigned)(size_t)lds + (unsigned)wid * 1024u;
    const int aoff = lds_byte(wr * 64 + fr, fq * 8);
    int boff = lds_byte(wc * 32 + fr, fq * 8) + 4 * HTB; asm volatile("" : "+v"(boff));
#define PG8_SA(b, h) (((b) * 2 + (h)) * HTB)
#define PG8_SB(b, h) ((4 + (b) * 2 + (h)) * HTB)
#define PG8_STAGE(bufoff, gbase, voff) do { glds16s<0, (bufoff)>((const char*)(gbase), (voff)[0], ldsb); glds16s<0, (bufoff) + 8192>((const char*)(gbase), (voff)[1], ldsb); } while (0)
#define PG8_STAGE1(bufoff, gbase, voff) do { glds16s<BK * 2, (bufoff)>((const char*)(gbase), (voff)[0], ldsb); glds16s<BK * 2, (bufoff) + 8192>((const char*)(gbase), (voff)[1], ldsb); } while (0)
#define PG8_LD2(dst, dst8, off) do { if constexpr (FP8) { const i32x4 lo_ = *(const LAS i32x4*)(lds + (off)), hi_ = *(const LAS i32x4*)(lds + (off) + 1024); dst8 = __builtin_shufflevector(lo_, hi_, 0, 1, 2, 3, 4, 5, 6, 7); } \
        else { dst[0] = *(const LAS bf16x8*)(lds + (off)); dst[1] = *(const LAS bf16x8*)(lds + (off) + 1024); } } while (0)
#define PG8_LDA(dst, b, h) do { const int aoff_ = aoff;   \
        _Pragma("unroll") for (int m = 0; m < 4; ++m) PG8_LD2(dst[m], dst##8[m], PG8_SA(b, h) + aoff_ + m * 2048); } while (0)
#define PG8_LDB(dst, b, h) do { _Pragma("unroll") for (int n = 0; n < 2; ++n) PG8_LD2(dst[n], dst##8[n], PG8_SB(b, h) - 4 * HTB + boff + n * 2048); } while (0)
#define PG8_MMA(ai, bj, At, Bt, Z) do { __builtin_amdgcn_s_setprio(1); _Pragma("unroll") for (int m = 0; m < 4; ++m) _Pragma("unroll") for (int n = 0; n < 2; ++n) { \
        const f32x4 c0_ = (Z) ? (f32x4){0.f, 0.f, 0.f, 0.f} : acc[ai][bj][m][n];     \
        if constexpr (FP8) acc[ai][bj][m][n] = __builtin_amdgcn_mfma_scale_f32_16x16x128_f8f6f4(Bt##8[n], At##8[m], c0_, 0, 0, 0, mxs_<Epi>(), 0, 0x7f7f7f7f); \
        else { acc[ai][bj][m][n] = __builtin_amdgcn_mfma_f32_16x16x32_bf16(Bt[n][0], At[m][0], c0_, 0, 0, 0); acc[ai][bj][m][n] = __builtin_amdgcn_mfma_f32_16x16x32_bf16(Bt[n][1], At[m][1], acc[ai][bj][m][n], 0, 0, 0); } } __builtin_amdgcn_s_setprio(0); } while (0)
#define PG8_WAIT_V(n) asm volatile("s_waitcnt vmcnt(" #n ")" ::: "memory")
#define PG8_WAIT_L(n) asm volatile("s_waitcnt lgkmcnt(" #n ")" ::: "memory")
#define PG8_BAR __builtin_amdgcn_s_barrier()
#define PG8_SCHED __builtin_amdgcn_sched_barrier(0)
    Unit cur, nxt; int ui = 0;
    if (!S.next(0, cur)) return;
    int ntc = S.unit_nt(cur, nt);
    Acc acc;
    const LAS float* rsl = (const LAS float*)(lds + RS_OFF);
#define PG8_RS_ISSUE(pm_) do { const int t_ = tid_laundered(wid); if constexpr (Epi::RSGATE) { if (t_ < 256) rp0.x = E.rowg[(pm_) * BM + t_]; }     \
        else { const float* pp_ = E.ps + (size_t)(unsigned)(((pm_) * BM + (t_ >> 1)) * 16 + 8 * (t_ & 1)); rp0 = *(const f32x4*)pp_; rp1 = *(const f32x4*)(pp_ + 4); } } while (0)
#define PG8_RS_COMMIT(slot_) do { const int t_ = tid_laundered(wid); if constexpr (Epi::RSGATE) { if (t_ < 256) ((LAS float*)(lds + RS_OFF))[(slot_) * 256 + t_] = rp0.x; } \
        else { float s_ = ((rp0.x + rp0.y) + (rp0.z + rp0.w)) + ((rp1.x + rp1.y) + (rp1.z + rp1.w)); s_ += shx(s_, 1); \
        if ((t_ & 1) == 0) ((LAS float*)(lds + RS_OFF))[(slot_) * 256 + (t_ >> 1)] = __builtin_amdgcn_rsqf(s_ * (1.0f / D) + NORM_EPS); } } while (0)
    f32x4 rp0, rp1;
    if constexpr (Epi::LDSRS) { PG8_RS_ISSUE(cur.pm); PG8_RS_COMMIT(0); }
    bf16x8 At[4][2], B0[2][2], B1[2][2]; i32x8 At8[4], B08[2], B18[2];
    const char* cA = S.a_ptr(cur); const char* cB = S.b_ptr(cur);
    PG8_STAGE(PG8_SB(0, 0), cB, voffB); PG8_STAGE(PG8_SB(0, 1), cB + hstepB, voffB); PG8_STAGE(PG8_SA(0, 0), cA, voffA); PG8_STAGE(PG8_SA(0, 1), cA + hstepA, voffA);
    if (wr == 1) PG8_BAR;
    PG8_WAIT_V(2); PG8_BAR;
    PG8_STAGE1(PG8_SB(1, 0), cB, voffB); PG8_STAGE1(PG8_SB(1, 1), cB + hstepB, voffB);
    PG8_WAIT_V(4); PG8_BAR;
    for (;;) {
        const bool has_next = S.next(ui + 1, nxt);
        const char* nA = has_next ? S.a_ptr(nxt) : cA; const char* nB = has_next ? S.b_ptr(nxt) : cB;
#define PG8_K2(Z) { \
            const bool last = (t == ntc - 2); \
            const char* a0 = cA + (size_t)t * kstep;                                                    \
            const char* a2 = last ? nA : cA + (size_t)(t + 2) * kstep; const char* b2 = last ? nB : cB + (size_t)(t + 2) * kstep; \
              \
            PG8_STAGE1(PG8_SA(1, 0), a0, voffA); PG8_STAGE1(PG8_SA(1, 1), a0 + hstepA, voffA); PG8_SCHED; PG8_LDB(B0, 0, 0); PG8_LDB(B1, 0, 1); PG8_SCHED; PG8_LDA(At, 0, 0); \
            PG8_WAIT_V(8); PG8_WAIT_L(0); PG8_BAR; PG8_MMA(0, 0, At, B0, Z); PG8_MMA(0, 1, At, B1, Z); PG8_BAR; PG8_SCHED; \
              \
            PG8_STAGE(PG8_SB(0, 0), b2, voffB); PG8_STAGE(PG8_SB(0, 1), b2 + hstepB, voffB); PG8_SCHED; PG8_LDA(At, 0, 1); \
            PG8_WAIT_V(4); PG8_WAIT_L(0); PG8_BAR; PG8_MMA(1, 0, At, B0, Z); PG8_MMA(1, 1, At, B1, Z); PG8_BAR; PG8_SCHED; \
              \
            PG8_STAGE(PG8_SA(0, 0), a2, voffA); PG8_STAGE(PG8_SA(0, 1), a2 + hstepA, voffA); PG8_SCHED; PG8_LDB(B0, 1, 0); PG8_LDB(B1, 1, 1); PG8_SCHED; PG8_LDA(At, 1, 0); \
            PG8_WAIT_V(8); PG8_WAIT_L(0); PG8_BAR; PG8_MMA(0, 0, At, B0, false); PG8_MMA(0, 1, At, B1, false); PG8_BAR; PG8_SCHED; \
              \
            PG8_STAGE1(PG8_SB(1, 0), b2, voffB); PG8_STAGE1(PG8_SB(1, 1), b2 + hstepB, voffB); PG8_SCHED; PG8_LDA(At, 1, 1); \
            PG8_WAIT_V(4); PG8_WAIT_L(0); PG8_BAR; PG8_MMA(1, 0, At, B0, false); PG8_MMA(1, 1, At, B1, false); PG8_BAR; PG8_SCHED; }
        { const int t = 0; PG8_K2(true) }
        for (int t = 2; t < ntc; t += 2) PG8_K2(false)
#undef PG8_K2
        if constexpr (Epi::LDSRS && (!FP8 || Epi::RSGATE)) { if (has_next) PG8_RS_ISSUE(nxt.pm); }
        if (wr == 0) PG8_BAR;
        E(acc, cur, wr, wc, fr, fq, rsl + (ui & 1) * 256);
        if constexpr (Epi::LDSRS && FP8 && !Epi::RSGATE) { if (has_next) PG8_RS_ISSUE(nxt.pm); }
        if constexpr (Epi::LDSRS) { if (has_next) PG8_RS_COMMIT((ui + 1) & 1); }
        if (!has_next) break;
        cur = nxt; cA = nA; cB = nB; ++ui; ntc = S.unit_nt(cur, nt);
        if (wr == 1) PG8_BAR;
    }
    PG8_WAIT_V(0);
    PG8_BAR;
#undef PG8_SA
#undef PG8_SB
#undef PG8_STAGE
#undef PG8_STAGE1
#undef PG8_LDA
#undef PG8_LDB
#undef PG8_MMA
#undef PG8_WAIT_V
#undef PG8_WAIT_L
#undef PG8_BAR
#undef PG8_SCHED
#undef PG8_RS_ISSUE
#undef PG8_RS_COMMIT
}

__device__ __forceinline__ f32x4 ps_load(const float* ps, int row, int fq) { return *(const f32x4*)(ps + (size_t)(unsigned)(row * 16 + 4 * fq)); }
__device__ __forceinline__ float ps_rstd(const f32x4 p) {
    float s = (p.x + p.y) + (p.z + p.w);
    s += shx(s, 16); s += shx(s, 32);
    return __builtin_amdgcn_rsqf(s * (1.0f / D) + NORM_EPS);
}
__device__ __forceinline__ void ps_rstd8(const float* ps, int row0, int fq, float (&rs)[8]) {
    f32x4 p[8];
#pragma unroll
    for (int g = 0; g < 8; ++g) p[g] = ps_load(ps, row0 + (g >> 2) * HALF + (g & 3) * 16, fq);
#pragma unroll
    for (int g = 0; g < 8; ++g) rs[g] = ps_rstd(p[g]);
}
template <int ACT> struct EpiBf16 {
    static constexpr bool PERM = true, LDSRS = true, RSGATE = false; static constexpr int MXSH = 0;
    bf16* O; int ldc; int act_pn; const float* ps;
    __device__ __forceinline__ void operator()(const Acc& acc, const Unit& u, int wr, int wc, int fr, int fq, const LAS float* rsl) const {
        const int row0 = u.pm * BM + wr * 64 + fr; const int col0 = u.pn * BM + wc * 32 + 8 * fq;
        const bool act = (ACT == 1) && (u.pn < act_pn);
        float rs8[8];
#pragma unroll
        for (int g = 0; g < 8; ++g) rs8[g] = rsl[wr * 64 + fr + (g >> 2) * HALF + (g & 3) * 16];
#pragma unroll
        for (int ai = 0; ai < 2; ++ai)
#pragma unroll
            for (int m = 0; m < 4; ++m) { bf16* rowp = O + (size_t)(row0 + ai * HALF + m * 16) * ldc + col0;
                const float rs = rs8[ai * 4 + m];
#pragma unroll
                for (int bj = 0; bj < 2; ++bj) { f32x4 v0 = acc[ai][bj][m][0] * rs, v1 = acc[ai][bj][m][1] * rs;
                    if (act) {
#pragma unroll
                        for (int q = 0; q < 4; ++q) { v0[q] = gelu_tanh(v0[q]); v1[q] = gelu_tanh(v1[q]); } }
                    u32x4 w; w.x = cvt_pk_bf16(v0[0], v0[1]); w.y = cvt_pk_bf16(v0[2], v0[3]); w.z = cvt_pk_bf16(v1[0], v1[1]); w.w = cvt_pk_bf16(v1[2], v1[3]);
                    *(u32x4*)(rowp + bj * HALF) = w; }
                asm volatile("" ::: "memory"); }
    }
};
struct EpiF8 {
    static constexpr bool PERM = true, LDSRS = false, RSGATE = false; static constexpr int MXSH = 0;
    unsigned char* O; int ldc;
    __device__ __forceinline__ void operator()(const Acc& acc, const Unit& u, int wr, int wc, int fr, int fq, const LAS float* rsl) const {
        const int row0 = u.pm * BM + wr * 64 + fr; const int col0 = u.pn * BM + wc * 32 + 8 * fq;
#pragma unroll
        for (int ai = 0; ai < 2; ++ai)
#pragma unroll
            for (int m = 0; m < 4; ++m) { unsigned char* rowp = O + (size_t)(unsigned)((row0 + ai * HALF + m * 16) * ldc + col0);
#pragma unroll
                for (int bj = 0; bj < 2; ++bj) { const f32x4 v0 = acc[ai][bj][m][0], v1 = acc[ai][bj][m][1];
                    u32x2 w; w.x = pk4_fp8(v0[0], v0[1], v0[2], v0[3]); w.y = pk4_fp8(v1[0], v1[1], v1[2], v1[3]); *(u32x2*)(rowp + bj * HALF) = w; } }
    }
};
struct EpiSwiglu {
    static constexpr bool PERM = true, LDSRS = false, RSGATE = false; static constexpr int MXSH = 0;
    bf16* O; int ldc; const float* ps;
    __device__ __forceinline__ void operator()(const Acc& acc, const Unit& u, int wr, int wc, int fr, int fq, const LAS float* rsl) const {
        const int row0 = u.pm * BM + wr * 64 + fr; const int col0 = u.pn * HALF + wc * 32 + 8 * fq;
        float rs8[8];
        if (ps) ps_rstd8(ps, row0, fq, rs8); else {
#pragma unroll
            for (int g = 0; g < 8; ++g) rs8[g] = 1.0f; }
#pragma unroll
        for (int ai = 0; ai < 2; ++ai)
#pragma unroll
            for (int m = 0; m < 4; ++m) { bf16* rowp = O + (size_t)(row0 + ai * HALF + m * 16) * ldc + col0;
                const float rs = rs8[ai * 4 + m];
                const f32x4 g0 = acc[ai][0][m][0] * rs, g1 = acc[ai][0][m][1] * rs, u0 = acc[ai][1][m][0] * rs, u1 = acc[ai][1][m][1] * rs;
                float o[8];
#pragma unroll
                for (int q = 0; q < 4; ++q) { o[q] = siluf_(g0[q]) * u0[q]; o[4 + q] = siluf_(g1[q]) * u1[q]; }
                u32x4 w; w.x = cvt_pk_bf16(o[0], o[1]); w.y = cvt_pk_bf16(o[2], o[3]); w.z = cvt_pk_bf16(o[4], o[5]); w.w = cvt_pk_bf16(o[6], o[7]);
                *(u32x4*)rowp = w; asm volatile("" ::: "memory"); }
    }
};
template <int SHU, bool HASPS> struct EpiSwigluF8 {
    static constexpr bool PERM = true, LDSRS = HASPS, RSGATE = false; static constexpr int MXSH = SHU;
    unsigned char* O; int ldc; const float* ps;
    __device__ __forceinline__ void operator()(const Acc& acc, const Unit& u, int wr, int wc, int fr, int fq, const LAS float* rsl) const {
        const int row0 = u.pm * BM + wr * 64 + fr; const int col0 = u.pn * HALF + wc * 32 + 8 * fq;
#pragma unroll
        for (int ai = 0; ai < 2; ++ai) {
            float rs4[4];
            if constexpr (HASPS) {
#pragma unroll
                for (int m = 0; m < 4; ++m) rs4[m] = rsl[wr * 64 + fr + ai * HALF + m * 16]; }
#pragma unroll
            for (int m = 0; m < 4; ++m) { unsigned char* rowp = O + (size_t)(unsigned)((row0 + ai * HALF + m * 16) * ldc + col0);
                f32x4 g0 = acc[ai][0][m][0], g1 = acc[ai][0][m][1], u0 = acc[ai][1][m][0], u1 = acc[ai][1][m][1];
                if constexpr (HASPS) { const float rs = rs4[m]; g0 = g0 * rs; g1 = g1 * rs; u0 = u0 * rs; u1 = u1 * rs; }
                float o[8];
#pragma unroll
                for (int q = 0; q < 4; ++q) { o[q] = siluf_(g0[q]) * u0[q]; o[4 + q] = siluf_(g1[q]) * u1[q]; }
                u32x2 w; w.x = pk4_fp8(o[0], o[1], o[2], o[3]); w.y = pk4_fp8(o[4], o[5], o[6], o[7]);
                *(u32x2*)rowp = w; asm volatile("" ::: "memory"); } }
    }
};
template <int XBF, int SH> struct EpiResBf16 {
    static constexpr bool PERM = true, LDSRS = false, RSGATE = false; static constexpr int MXSH = SH;
    bf16* X; unsigned char* x8; float* ps;
    __device__ __forceinline__ void operator()(const Acc& acc, const Unit& u, int wr, int wc, int fr, int fq, const LAS float* rsl) const {
        const int row0 = u.pm * BM + wr * 64 + fr, col0 = u.pn * BM + wc * 32 + 8 * fq;
#pragma unroll
        for (int ai = 0; ai < 2; ++ai)
#pragma unroll
            for (int m = 0; m < 4; ++m) { const int row = row0 + ai * HALF + m * 16; const unsigned off = (unsigned)(row * D + col0);
                u32x4 r[2];
#pragma unroll
                for (int bj = 0; bj < 2; ++bj) r[bj] = *(const u32x4*)(X + off + bj * HALF);
                float ss = 0.f;
#pragma unroll
                for (int bj = 0; bj < 2; ++bj) {
                    const f32x4 v0 = (f32x4){bflo(r[bj].x), bfhi(r[bj].x), bflo(r[bj].y), bfhi(r[bj].y)} + acc[ai][bj][m][0];
                    const f32x4 v1 = (f32x4){bflo(r[bj].z), bfhi(r[bj].z), bflo(r[bj].w), bfhi(r[bj].w)} + acc[ai][bj][m][1];
                    u32x4 w; w.x = cvt_pk_bf16(v0.x, v0.y); w.y = cvt_pk_bf16(v0.z, v0.w); w.z = cvt_pk_bf16(v1.x, v1.y); w.w = cvt_pk_bf16(v1.z, v1.w);
                    *(u32x4*)(X + off + bj * HALF) = w;
                    if constexpr (XBF == 2) { u32x2 w8; w8.x = pk4_fp8(v0.x, v0.y, v0.z, v0.w); w8.y = pk4_fp8(v1.x, v1.y, v1.z, v1.w); *(u32x2*)(x8 + off + bj * HALF) = w8; }
                    ss += ((v0.x * v0.x + v0.y * v0.y) + (v0.z * v0.z + v0.w * v0.w)) + ((v1.x * v1.x + v1.y * v1.y) + (v1.z * v1.z + v1.w * v1.w)); }
                if (ps) { ss += shx(ss, 16); ss += shx(ss, 32); if (fq == 0) ps[(size_t)row * 16 + u.pn * 4 + wc] = ss; }
                asm volatile("" ::: "memory"); }
    }
};
struct EpiMoeDown {
    static constexpr bool PERM = true, LDSRS = true, RSGATE = true; static constexpr int MXSH = WDN_SH;
    bf16* out; float* part; const float* rowg;
    __device__ __forceinline__ void operator()(const Acc& acc, const Unit& u, int wr, int wc, int fr, int fq, const LAS float* rsl) const {
        const int row0 = u.pm * BM + wr * 64 + fr, col0 = u.pn * BM + wc * 32 + 8 * fq;
#pragma unroll
        for (int ai = 0; ai < 2; ++ai)
#pragma unroll
            for (int m = 0; m < 4; ++m) { const int row = row0 + ai * HALF + m * 16; const float g = rsl[wr * 64 + fr + ai * HALF + m * 16];
                if (u.ks < 0) { bf16* rowp = out + (size_t)(unsigned)(row * D + col0);
#pragma unroll
                    for (int bj = 0; bj < 2; ++bj) { const f32x4 v0 = acc[ai][bj][m][0] * g, v1 = acc[ai][bj][m][1] * g;
                        u32x4 w; w.x = cvt_pk_bf16(v0[0], v0[1]); w.y = cvt_pk_bf16(v0[2], v0[3]); w.z = cvt_pk_bf16(v1[0], v1[1]); w.w = cvt_pk_bf16(v1[2], v1[3]);
                        *(u32x4*)(rowp + bj * HALF) = w; } }
                else { float* rowp = part + (size_t)(unsigned)((u.ks * DTAILROWS + (row - DTAILROW0)) * D + col0);
#pragma unroll
                    for (int bj = 0; bj < 2; ++bj) { *(f32x4*)(rowp + bj * HALF) = acc[ai][bj][m][0] * g; *(f32x4*)(rowp + bj * HALF + 4) = acc[ai][bj][m][1] * g; } } }
    }
};
}

struct Args { const float* in[25]; float* out; unsigned char* ws; int ph_lo, ph_hi; };
enum { I_X = 0, I_NMIX, I_NFFN, I_HYWIN, I_QGAIN, I_KGAIN, I_SINKS, I_HYCONV, I_HYWOUT, I_RGWIN, I_RGCONVW, I_RGCONVB, I_GAW, I_GAB, I_GXW, I_GXB, I_LAM, I_RGWOUT,
       I_FFNG, I_FFNU, I_FFND, I_ROUTER, I_MOEG, I_MOEU, I_MOED };

__device__ __forceinline__ void cvt_item(const float* W, int N, bf16* WT, int ldk, int k0, int n0, int drow0, const float* kscale, LAS unsigned* scr, int lane) {
    const int lg = lane & 15, kq = lane >> 4;
    const float* src = W + (size_t)(k0 + 2 * kq) * N + n0 + 4 * lg;
    f32x4 v0[8], v1[8];
#pragma unroll
    for (int s = 0; s < 8; ++s) { v0[s] = *(const f32x4*)(src + (size_t)(8 * s) * N); v1[s] = *(const f32x4*)(src + (size_t)(8 * s + 1) * N); }
    if (kscale) {
#pragma unroll
        for (int s = 0; s < 8; ++s) { const float g0 = kscale[k0 + 2 * kq + 8 * s], g1 = kscale[k0 + 2 * kq + 8 * s + 1]; v0[s] = v0[s] * g0; v1[s] = v1[s] * g1; } }
    const int swz = 4 * (lg & 7);
#pragma unroll
    for (int s = 0; s < 8; ++s) { const int kp = 4 * s + kq;
#pragma unroll
        for (int i = 0; i < 4; ++i) scr[(4 * lg + i) * 32 + (kp ^ swz)] = cvt_pk_bf16(v0[s][i], v1[s][i]); }
    LDS_WAIT(); asm volatile("" ::: "memory");
    const int c = lane & 7;
#pragma unroll
    for (int j = 0; j < 8; ++j) { const int n = 8 * j + (lane >> 3);
        const u32x4 o = *(const LAS u32x4*)(scr + n * 32 + 4 * (c ^ ((n >> 2) & 7)));
        *(u32x4*)(WT + (size_t)(drow0 + n) * ldk + k0 + 8 * c) = o; }
    LDS_WAIT(); asm volatile("" ::: "memory");
}
template <int MODE>
__device__ __forceinline__ void cvt_class(const float* src, int K, int N, int nmat, bf16* dst, size_t dst_stride, const float* kscale, int kstride, int gw, int NGW, LAS unsigned* scr, int lane, int& base) {
    const int nkb = K / 64, nnb = N / 64, per = nkb * nnb, total = per * nmat;
    int first = gw - base % NGW; if (first < 0) first += NGW; base += total;
    for (int it = first; it < total; it += NGW) {
        const int mat = it / per, r = it - mat * per, kb = r / nnb, nb = r - kb * nnb, n0 = nb * 64;
        const int drow0 = (MODE == 0) ? n0 : (256 * (n0 >> 7) + (n0 & 127) + (MODE == 2 ? 128 : 0));
        cvt_item(src + (size_t)mat * K * N, N, dst + (size_t)mat * dst_stride, K, kb * 64, n0, drow0, kscale ? kscale + mat * kstride : nullptr, scr, lane);
    }
}

__device__ __forceinline__ void cvt_item_f8(const float* W, int N, unsigned char* WT, int ldk, int k0, int n0, int drow0, float scale, const float* kscale, LAS unsigned* scr, int lane) {
    const int lg = lane & 15, kq = lane >> 4;
    const float* src = W + (size_t)(k0 + 4 * kq) * N + n0 + 4 * lg;
    f32x4 v[4][4];
#pragma unroll
    for (int s = 0; s < 4; ++s)
#pragma unroll
        for (int j = 0; j < 4; ++j) v[s][j] = *(const f32x4*)(src + (size_t)(16 * s + j) * N);
    float sc[4][4];
#pragma unroll
    for (int s = 0; s < 4; ++s)
#pragma unroll
        for (int j = 0; j < 4; ++j) sc[s][j] = kscale ? scale * kscale[k0 + 4 * kq + 16 * s + j] : scale;
#pragma unroll
    for (int s = 0; s < 4; ++s)
#pragma unroll
        for (int i = 0; i < 4; ++i) scr[(4 * lg + i) * 16 + 4 * (s ^ (lg & 3)) + kq] = pk4_fp8(v[s][0][i] * sc[s][0], v[s][1][i] * sc[s][1], v[s][2][i] * sc[s][2], v[s][3][i] * sc[s][3]);
    LDS_WAIT(); asm volatile("" ::: "memory");
    const int c = lane & 3;
#pragma unroll
    for (int j = 0; j < 4; ++j) { const int n = 16 * j + (lane >> 2);
        const u32x4 o = *(const LAS u32x4*)(scr + n * 16 + 4 * (c ^ ((n >> 2) & 3)));
        *(u32x4*)(WT + (size_t)(drow0 + n) * ldk + k0 + 16 * c) = o; }
    LDS_WAIT(); asm volatile("" ::: "memory");
}
template <int MODE>
__device__ __forceinline__ void cvt_class_f8(const float* src, int K, int N, int nmat, unsigned char* dst, size_t dst_stride, float scale, const float* kscale, int gw, int NGW, LAS unsigned* scr, int lane, int& base, int r_lo = 0, int r_hi = 1 << 30) {
    const int nkb = K / 64, nnb = N / 64, perm = nkb * nnb, r0 = r_lo, per = (r_hi < perm ? r_hi : perm) - r0, total = per * nmat;
    int first = gw - base % NGW; if (first < 0) first += NGW; base += total;
    for (int it = first; it < total; it += NGW) {
        const int mat = it / per, r = r0 + it - mat * per, kb = r / nnb, nb = r - kb * nnb, n0 = nb * 64;
        const int drow0 = (MODE == 0) ? n0 : (256 * (n0 >> 7) + (n0 & 127) + (MODE == 2 ? 128 : 0));
        cvt_item_f8(src + (size_t)mat * K * N, N, dst + (size_t)mat * dst_stride, K, kb * 64, n0, drow0, scale, kscale, scr, lane);
    }
}

__device__ __forceinline__ void norm_store(const f32x4 (&v)[4], const float* gain, bf16* orow, int lane) {
    float ss = 0.f;
#pragma unroll
    for (int j = 0; j < 4; ++j) ss += (v[j].x * v[j].x + v[j].y * v[j].y) + (v[j].z * v[j].z + v[j].w * v[j].w);
    const float rstd = 1.0f / sqrtf(wave_sum(ss) * (1.0f / D) + NORM_EPS);
#pragma unroll
    for (int j = 0; j < 4; ++j) { const f32x4 g = *(const f32x4*)(gain + 256 * j + 4 * lane); const f32x4 o = v[j] * rstd * g;
        u32x2 w; w.x = cvt_pk_bf16(o.x, o.y); w.y = cvt_pk_bf16(o.z, o.w); *(u32x2*)(orow + 256 * j + 4 * lane) = w; }
}
__device__ __forceinline__ void xb_store(const f32x4 (&v)[4], bf16* orow, float* psrow, int lane) {
    float ss = 0.f;
#pragma unroll
    for (int j = 0; j < 4; ++j) { ss += (v[j].x * v[j].x + v[j].y * v[j].y) + (v[j].z * v[j].z + v[j].w * v[j].w);
        u32x2 w; w.x = cvt_pk_bf16(v[j].x, v[j].y); w.y = cvt_pk_bf16(v[j].z, v[j].w); *(u32x2*)(orow + 256 * j + 4 * lane) = w; }
    ss = wave_sum(ss);
    if (lane < 16) psrow[lane] = (lane == 0) ? ss : 0.f;
}
__device__ __forceinline__ void phase_xb(const float* X, bf16* XB, float* PS, int gw, int NGW, int lane) {
    for (int m = gw; m < M; m += NGW) { const f32x4* xr = (const f32x4*)(X + (size_t)m * D) + lane; f32x4 v[4];
#pragma unroll
        for (int j = 0; j < 4; ++j) v[j] = xr[64 * j];
        xb_store(v, XB + (size_t)m * D, PS + (size_t)m * 16, lane); }
}
__device__ __forceinline__ void norm_store_f8(const f32x4 (&v)[4], const float* gain, unsigned char* orow, int lane) {
    float ss = 0.f;
#pragma unroll
    for (int j = 0; j < 4; ++j) ss += (v[j].x * v[j].x + v[j].y * v[j].y) + (v[j].z * v[j].z + v[j].w * v[j].w);
    const float rstd = 1.0f / sqrtf(wave_sum(ss) * (1.0f / D) + NORM_EPS);
#pragma unroll
    for (int j = 0; j < 4; ++j) { const f32x4 g = *(const f32x4*)(gain + 256 * j + 4 * lane); const f32x4 o = v[j] * rstd * g;
        *(unsigned*)(orow + 256 * j + 4 * lane) = pk4_fp8(o.x, o.y, o.z, o.w); }
}
__device__ __forceinline__ void phase_norm_f8(const float* X, const float* gain, unsigned char* H, int gw, int NGW, int lane) {
    for (int m = gw; m < M; m += NGW) { const f32x4* xr = (const f32x4*)(X + (size_t)m * D) + lane; f32x4 v[4];
#pragma unroll
        for (int j = 0; j < 4; ++j) v[j] = xr[64 * j];
        norm_store_f8(v, gain, H + (size_t)m * D, lane); }
}
__device__ __forceinline__ void phase_norm(const float* X, const float* gain, bf16* H, int gw, int NGW, int lane) {
    for (int m = gw; m < M; m += NGW) { const f32x4* xr = (const f32x4*)(X + (size_t)m * D) + lane; f32x4 v[4];
#pragma unroll
        for (int j = 0; j < 4; ++j) v[j] = xr[64 * j];
        norm_store(v, gain, H + (size_t)m * D, lane); }
}

constexpr int KS_LD = 72, VT_LD = 264;
constexpr int ATT_KS = 0, ATT_VT = 256 * KS_LD * 2;
__device__ __forceinline__ void attn_unit(LAS unsigned char* lds, const bf16* P, bf16* MIX, const float* qg, const float* kg, const float* sinks, int b, int n, int kh, int wv) {
    const int tid = tid_laundered(wv), lane = tid & 63, wave = tid >> 6, fr = lane & 15, fq = lane >> 4;
    LAS bf16* Ks = (LAS bf16*)(lds + ATT_KS); LAS bf16* Vt = (LAS bf16*)(lds + ATT_VT);
    const int rowb = b * SEQ + (n - 1) * 128;
    { const int dch = tid & 7;
      float kgv[8];
#pragma unroll
      for (int j = 0; j < 8; ++j) kgv[j] = kg[8 * dch + j];
#pragma unroll
      for (int p = 0; p < 4; ++p) { const int key = p * 64 + (tid >> 3); const bool ok = (n > 0) || (key >= 128);
        u32x4 kw = (u32x4){0u, 0u, 0u, 0u}, vw = (u32x4){0u, 0u, 0u, 0u};
        if (ok) { const bf16* rp = P + (size_t)(rowb + key) * EIN; kw = *(const u32x4*)(rp + 512 + kh * 64 + 8 * dch); vw = *(const u32x4*)(rp + 640 + kh * 64 + 8 * dch); }
        float kf[8] = {bflo(kw.x), bfhi(kw.x), bflo(kw.y), bfhi(kw.y), bflo(kw.z), bfhi(kw.z), bflo(kw.w), bfhi(kw.w)};
        float ss = 0.f;
#pragma unroll
        for (int j = 0; j < 8; ++j) ss += kf[j] * kf[j];
        ss += shx(ss, 1); ss += shx(ss, 2); ss += shx(ss, 4);
        const float rstd = 1.0f / sqrtf(ss * (1.0f / 64.0f) + NORM_EPS);
        u32x4 ko; ko.x = cvt_pk_bf16(kf[0] * rstd * kgv[0], kf[1] * rstd * kgv[1]); ko.y = cvt_pk_bf16(kf[2] * rstd * kgv[2], kf[3] * rstd * kgv[3]);
        ko.z = cvt_pk_bf16(kf[4] * rstd * kgv[4], kf[5] * rstd * kgv[5]); ko.w = cvt_pk_bf16(kf[6] * rstd * kgv[6], kf[7] * rstd * kgv[7]);
        *(LAS u32x4*)(Ks + key * KS_LD + 8 * dch) = ko;
        const unsigned vv[4] = {vw.x, vw.y, vw.z, vw.w};
#pragma unroll
        for (int j = 0; j < 4; ++j) { Vt[(8 * dch + 2 * j) * VT_LD + key] = (bf16)(vv[j] & 0xffffu); Vt[(8 * dch + 2 * j + 1) * VT_LD + key] = (bf16)(vv[j] >> 16); }
      } }
    const int g = wave >> 1, qh = wave & 1, hq = kh * 4 + g;
    bf16x8 Qf[4][2];
    { float qgv[2][8];
#pragma unroll
      for (int s = 0; s < 2; ++s)
#pragma unroll
          for (int j = 0; j < 8; ++j) qgv[s][j] = qg[32 * s + 8 * fq + j] * 0.125f;
#pragma unroll
      for (int qt = 0; qt < 4; ++qt) { const int row = b * SEQ + n * 128 + 64 * qh + 16 * qt + fr; const bf16* rp = P + (size_t)row * EIN + hq * 64 + 8 * fq;
        const u32x4 w0 = *(const u32x4*)rp, w1 = *(const u32x4*)(rp + 32);
        float q0[8] = {bflo(w0.x), bfhi(w0.x), bflo(w0.y), bfhi(w0.y), bflo(w0.z), bfhi(w0.z), bflo(w0.w), bfhi(w0.w)};
        float q1[8] = {bflo(w1.x), bfhi(w1.x), bflo(w1.y), bfhi(w1.y), bflo(w1.z), bfhi(w1.z), bflo(w1.w), bfhi(w1.w)};
        float ss = 0.f;
#pragma unroll
        for (int j = 0; j < 8; ++j) ss += q0[j] * q0[j] + q1[j] * q1[j];
        ss += shx(ss, 16); ss += shx(ss, 32);
        const float rstd = 1.0f / sqrtf(ss * (1.0f / 64.0f) + NORM_EPS);
        u32x4 a, c;
        a.x = cvt_pk_bf16(q0[0] * rstd * qgv[0][0], q0[1] * rstd * qgv[0][1]); a.y = cvt_pk_bf16(q0[2] * rstd * qgv[0][2], q0[3] * rstd * qgv[0][3]);
        a.z = cvt_pk_bf16(q0[4] * rstd * qgv[0][4], q0[5] * rstd * qgv[0][5]); a.w = cvt_pk_bf16(q0[6] * rstd * qgv[0][6], q0[7] * rstd * qgv[0][7]);
        c.x = cvt_pk_bf16(q1[0] * rstd * qgv[1][0], q1[1] * rstd * qgv[1][1]); c.y = cvt_pk_bf16(q1[2] * rstd * qgv[1][2], q1[3] * rstd * qgv[1][3]);
        c.z = cvt_pk_bf16(q1[4] * rstd * qgv[1][4], q1[5] * rstd * qgv[1][5]); c.w = cvt_pk_bf16(q1[6] * rstd * qgv[1][6], q1[7] * rstd * qgv[1][7]);
        Qf[qt][0] = __builtin_bit_cast(bf16x8, a); Qf[qt][1] = __builtin_bit_cast(bf16x8, c); } }
    __syncthreads();
    const float slope = exp2f(-(float)(hq + 1)); const float sink = sinks[hq];
#pragma unroll
    for (int qt = 0; qt < 4; ++qt) {
        const int tq0 = 64 * qh + 16 * qt; const int kt0 = (tq0 >> 4) < 6 ? (tq0 >> 4) : 6;
        f32x4 S[10];
#pragma unroll
        for (int kk = 0; kk < 10; ++kk) { S[kk] = (f32x4){0.f, 0.f, 0.f, 0.f};
#pragma unroll
            for (int s = 0; s < 2; ++s) { const bf16x8 Kf = *(const LAS bf16x8*)(Ks + (16 * (kt0 + kk) + fr) * KS_LD + 32 * s + 8 * fq);
                S[kk] = __builtin_amdgcn_mfma_f32_16x16x32_bf16(Kf, Qf[qt][s], S[kk], 0, 0, 0); } }
        const int tqq = tq0 + fr; float mx = sink;
#pragma unroll
        for (int kk = 0; kk < 10; ++kk)
#pragma unroll
            for (int i = 0; i < 4; ++i) { const int sb = 16 * (kt0 + kk) + 4 * fq + i; const int diff = 128 + tqq - sb;
                const bool valid = (diff >= 0) && (diff < 128) && ((n > 0) || (sb >= 128));
                const float v = valid ? (S[kk][i] - slope * (float)diff) : -1e30f; S[kk][i] = v; mx = fmaxf(mx, v); }
        mx = fmaxf(mx, shx(mx, 16)); mx = fmaxf(mx, shx(mx, 32));
        float l = 0.f;
#pragma unroll
        for (int kk = 0; kk < 10; ++kk)
#pragma unroll
            for (int i = 0; i < 4; ++i) { const float p = fast_exp(S[kk][i] - mx); S[kk][i] = p; l += p; }
        l += shx(l, 16); l += shx(l, 32);
        l += fast_exp(sink - mx);
        const float inv = 1.0f / l;
        f32x4 O[4];
#pragma unroll
        for (int dt = 0; dt < 4; ++dt) O[dt] = (f32x4){0.f, 0.f, 0.f, 0.f};
#pragma unroll
        for (int pp = 0; pp < 5; ++pp) { u32x4 pw; pw.x = cvt_pk_bf16(S[2 * pp][0], S[2 * pp][1]); pw.y = cvt_pk_bf16(S[2 * pp][2], S[2 * pp][3]);
            pw.z = cvt_pk_bf16(S[2 * pp + 1][0], S[2 * pp + 1][1]); pw.w = cvt_pk_bf16(S[2 * pp + 1][2], S[2 * pp + 1][3]);
            const bf16x8 Pf = __builtin_bit_cast(bf16x8, pw);
#pragma unroll
            for (int dt = 0; dt < 4; ++dt) { const LAS bf16* vp = Vt + (16 * dt + fr) * VT_LD + 16 * (kt0 + 2 * pp) + 4 * fq;
                const u32x2 va = *(const LAS u32x2*)vp, vb = *(const LAS u32x2*)(vp + 16);
                u32x4 vw; vw.x = va.x; vw.y = va.y; vw.z = vb.x; vw.w = vb.y;
                O[dt] = __builtin_amdgcn_mfma_f32_16x16x32_bf16(__builtin_bit_cast(bf16x8, vw), Pf, O[dt], 0, 0, 0); } }
        bf16* op = MIX + (size_t)(b * SEQ + n * 128 + tqq) * D + hq * 64 + 4 * fq;
#pragma unroll
        for (int dt = 0; dt < 4; ++dt) { u32x2 w; w.x = cvt_pk_bf16(O[dt][0] * inv, O[dt][1] * inv); w.y = cvt_pk_bf16(O[dt][2] * inv, O[dt][3] * inv); *(u32x2*)(op + 16 * dt) = w; }
    }
    __syncthreads();
}
__device__ __forceinline__ void phase_attn_conv(LAS unsigned char* lds, const bf16* P, bf16* MIX, const float* qg, const float* kg, const float* sinks, const float* convw, int bid, int G, int wv) {
    for (int u = bid; u < BATCH * 16 * 2; u += G) { const int kh = u & 1, n = (u >> 1) & 15, b = u >> 5; attn_unit(lds, P, MIX, qg, kg, sinks, b, n, kh, wv); }
    const int tid = tid_laundered(wv), cg = tid & 63, rsub = tid >> 6, c0 = 8 * cg;
    float w[3][8];
#pragma unroll
    for (int k = 0; k < 3; ++k)
#pragma unroll
        for (int i = 0; i < 8; ++i) w[k][i] = convw[k * 512 + c0 + i];
    for (int r64 = bid; r64 < M / 64; r64 += G) { const int row0 = r64 * 64 + rsub * 8, t0 = row0 & (SEQ - 1);
        u32x4 gc[10], uu[10], gb[8];
#pragma unroll
        for (int j = 0; j < 10; ++j) { gc[j] = (u32x4){0u, 0u, 0u, 0u}; uu[j] = (u32x4){0u, 0u, 0u, 0u};
            if (t0 - 2 + j >= 0) { const bf16* rp = P + (size_t)(row0 - 2 + j) * EIN; gc[j] = *(const u32x4*)(rp + 1280 + c0); uu[j] = *(const u32x4*)(rp + 1792 + c0); } }
#pragma unroll
        for (int r = 0; r < 8; ++r) gb[r] = *(const u32x4*)(P + (size_t)(row0 + r) * EIN + 768 + c0);
#pragma unroll
        for (int r = 0; r < 8; ++r) { float acc[8];
#pragma unroll
            for (int i = 0; i < 8; ++i) acc[i] = 0.f;
#pragma unroll
            for (int k = 0; k < 3; ++k) { const unsigned gw_[4] = {gc[r + k].x, gc[r + k].y, gc[r + k].z, gc[r + k].w}, uw[4] = {uu[r + k].x, uu[r + k].y, uu[r + k].z, uu[r + k].w};
#pragma unroll
                for (int q = 0; q < 4; ++q) { acc[2 * q] += w[k][2 * q] * (bflo(gw_[q]) * bflo(uw[q])); acc[2 * q + 1] += w[k][2 * q + 1] * (bfhi(gw_[q]) * bfhi(uw[q])); } }
            const unsigned gbw[4] = {gb[r].x, gb[r].y, gb[r].z, gb[r].w}; u32x4 o; unsigned ow[4];
#pragma unroll
            for (int q = 0; q < 4; ++q) ow[q] = cvt_pk_bf16(bflo(gbw[q]) * acc[2 * q], bfhi(gbw[q]) * acc[2 * q + 1]);
            o.x = ow[0]; o.y = ow[1]; o.z = ow[2]; o.w = ow[3];
            *(u32x4*)(MIX + (size_t)(row0 + r) * D + 512 + c0) = o; } }
}

__device__ __forceinline__ void phase_conv4(const bf16* P, bf16* XC, const float* cw, const float* cb, int bid, int G, int wv) {
    const int tid = tid_laundered(wv), cg = tid & 127, rsub = tid >> 7, c0 = 8 * cg;
    float w[4][8], bias[8];
#pragma unroll
    for (int k = 0; k < 4; ++k)
#pragma unroll
        for (int i = 0; i < 8; ++i) w[k][i] = cw[k * D + c0 + i];
#pragma unroll
    for (int i = 0; i < 8; ++i) bias[i] = cb[c0 + i];
    for (int r32 = bid; r32 < M / 32; r32 += G) { const int row0 = r32 * 32 + rsub * 8, t0 = row0 & (SEQ - 1);
        u32x4 xv[11];
#pragma unroll
        for (int j = 0; j < 11; ++j) { xv[j] = (u32x4){0u, 0u, 0u, 0u}; if (t0 - 3 + j >= 0) xv[j] = *(const u32x4*)(P + (size_t)(row0 - 3 + j) * 2048 + 1024 + c0); }
#pragma unroll
        for (int r = 0; r < 8; ++r) { float acc[8];
#pragma unroll
            for (int i = 0; i < 8; ++i) acc[i] = bias[i];
#pragma unroll
            for (int k = 0; k < 4; ++k) { const unsigned xw[4] = {xv[r + k].x, xv[r + k].y, xv[r + k].z, xv[r + k].w};
#pragma unroll
                for (int j = 0; j < 4; ++j) { acc[2 * j] += w[k][2 * j] * bflo(xw[j]); acc[2 * j + 1] += w[k][2 * j + 1] * bfhi(xw[j]); } }
            u32x4 o; o.x = cvt_pk_bf16(acc[0], acc[1]); o.y = cvt_pk_bf16(acc[2], acc[3]); o.z = cvt_pk_bf16(acc[4], acc[5]); o.w = cvt_pk_bf16(acc[6], acc[7]);
            *(u32x4*)(XC + (size_t)(row0 + r) * D + c0) = o; } }
}
__device__ __forceinline__ void conv4_tile(const bf16* P, bf16* XC, const float* cw, const float* cb, int pm, int head, int tid) {
    const int cg = tid & 15, rg = tid >> 4, c0 = 128 * head + 8 * cg, row0 = 256 * pm + 8 * rg, t0 = row0 & (SEQ - 1);
    float w[4][8], bias[8];
#pragma unroll
    for (int k = 0; k < 4; ++k)
#pragma unroll
        for (int i = 0; i < 8; ++i) w[k][i] = cw[k * D + c0 + i];
#pragma unroll
    for (int i = 0; i < 8; ++i) bias[i] = cb[c0 + i];
    u32x4 xv[11];
#pragma unroll
    for (int j = 0; j < 11; ++j) { xv[j] = (u32x4){0u, 0u, 0u, 0u}; if (t0 - 3 + j >= 0) xv[j] = *(const u32x4*)(P + (size_t)(row0 - 3 + j) * 2048 + 1024 + c0); }
#pragma unroll
    for (int r = 0; r < 8; ++r) { float acc[8];
#pragma unroll
        for (int i = 0; i < 8; ++i) acc[i] = bias[i];
#pragma unroll
        for (int k = 0; k < 4; ++k) { const unsigned xw[4] = {xv[r + k].x, xv[r + k].y, xv[r + k].z, xv[r + k].w};
#pragma unroll
            for (int j = 0; j < 4; ++j) { acc[2 * j] += w[k][2 * j] * bflo(xw[j]); acc[2 * j + 1] += w[k][2 * j + 1] * bfhi(xw[j]); } }
        u32x4 o; o.x = cvt_pk_bf16(acc[0], acc[1]); o.y = cvt_pk_bf16(acc[2], acc[3]); o.z = cvt_pk_bf16(acc[4], acc[5]); o.w = cvt_pk_bf16(acc[6], acc[7]);
        *(u32x4*)(XC + (size_t)(row0 + r) * D + c0) = o; }
}
struct LruConst { f32x2 ba, bx, sp8; };
__device__ __forceinline__ LruConst lru_const(const float* ga_b, const float* gx_b, const float* lam, int c) {
    LruConst k; k.ba = *(const f32x2*)(ga_b + c); k.bx = *(const f32x2*)(gx_b + c); const f32x2 l = *(const f32x2*)(lam + c);
    const float z0 = -l.x, z1 = -l.y;
    k.sp8.x = 8.0f * ((z0 > 0.f ? z0 : 0.f) + log1pf(__expf(-fabsf(z0)))); k.sp8.y = 8.0f * ((z1 > 0.f ? z1 : 0.f) + log1pf(__expf(-fabsf(z1)))); return k;
}
__device__ __forceinline__ float one_minus_exp(float x) {
    const float s = -x * (1.0f + x * 0.5f * (1.0f + x * (1.0f / 3.0f) * (1.0f + x * 0.25f * (1.0f + x * 0.2f))));
    return x > -0.1f ? s : 1.0f - __expf(x);
}
__device__ __forceinline__ void lru_ab_f(const LruConst& k, f32x2 ga, f32x2 gx, f32x2 xc, bool first, f32x2& a, f32x2& b) {
    const float r0 = sigmoidf_(ga.x + k.ba.x), r1 = sigmoidf_(ga.y + k.ba.y), i0 = sigmoidf_(gx.x + k.bx.x), i1 = sigmoidf_(gx.y + k.bx.y);
    const float la0 = -r0 * k.sp8.x, la1 = -r1 * k.sp8.y;
    a.x = fast_exp(la0); a.y = fast_exp(la1);
    float m0 = __builtin_amdgcn_sqrtf(fmaxf(__builtin_fmaf(-a.x, a.x, 1.0f), 0.f)), m1 = __builtin_amdgcn_sqrtf(fmaxf(__builtin_fmaf(-a.y, a.y, 1.0f), 0.f));
    if (first) { m0 = 1.0f; m1 = 1.0f; }
    b.x = m0 * (i0 * xc.x); b.y = m1 * (i1 * xc.y);
}
__device__ __forceinline__ void lru_ab4(const LruConst& k0, const LruConst& k1, unsigned gaw, unsigned gxw, u32x2 xcw, bool first, f32x4& a, f32x4& b) {
    const f32x2 ga0 = __builtin_amdgcn_cvt_pk_f32_fp8(gaw, false), ga1 = __builtin_amdgcn_cvt_pk_f32_fp8(gaw, true), gx0 = __builtin_amdgcn_cvt_pk_f32_fp8(gxw, false), gx1 = __builtin_amdgcn_cvt_pk_f32_fp8(gxw, true);
    f32x2 a0, b0, a1, b1;
    lru_ab_f(k0, ga0, gx0, (f32x2){bflo(xcw.x), bfhi(xcw.x)}, first, a0, b0);
    lru_ab_f(k1, ga1, gx1, (f32x2){bflo(xcw.y), bfhi(xcw.y)}, first, a1, b1);
    a = (f32x4){a0.x, a0.y, a1.x, a1.y}; b = (f32x4){b0.x, b0.y, b1.x, b1.y};
}
__device__ __forceinline__ void phase_scan1(const unsigned char* GT, const bf16* XC, const float* ga_b, const float* gx_b, const float* lam, float* CARA, float* CARH, int bid, int G, int wv) {
    const int tid = tid_laundered(wv), sub = tid >> 8, c = 4 * (tid & 255); const int gcol = 256 * (c >> 7) + (c & 127);
    const LruConst k0 = lru_const(ga_b, gx_b, lam, c), k1 = lru_const(ga_b, gx_b, lam, c + 2);
    for (int it = 2 * bid + sub; it < BATCH * NSCH; it += 2 * G) { const int b = it / NSCH, ch = it % NSCH; const size_t row0 = (size_t)(b * SEQ + ch * SCH);
        f32x4 ap = (f32x4){1.f, 1.f, 1.f, 1.f}, h = (f32x4){0.f, 0.f, 0.f, 0.f};
#pragma unroll 8
        for (int t = 0; t < SCH; ++t) { const size_t r = row0 + t; const unsigned gaw = *(const unsigned*)(GT + r * 2048 + gcol), gxw = *(const unsigned*)(GT + r * 2048 + gcol + 128); const u32x2 xcw = *(const u32x2*)(XC + r * D + c);
            f32x4 a, bb; lru_ab4(k0, k1, gaw, gxw, xcw, (ch == 0) && (t == 0), a, bb); h = a * h + bb; ap = ap * a; }
        *(f32x4*)(CARA + (size_t)it * D + c) = ap; *(f32x4*)(CARH + (size_t)it * D + c) = h; }
}
__device__ __forceinline__ void phase_scan2(const unsigned char* GT, const bf16* XC, const float* ga_b, const float* gx_b, const float* lam, const float* CARA, const float* CARH, const bf16* P, bf16* MIX, int bid, int G, int wv) {
    const int tid = tid_laundered(wv), sub = tid >> 8, c = 4 * (tid & 255); const int gcol = 256 * (c >> 7) + (c & 127);
    const LruConst k0 = lru_const(ga_b, gx_b, lam, c), k1 = lru_const(ga_b, gx_b, lam, c + 2);
    for (int it = 2 * bid + sub; it < BATCH * NSCH; it += 2 * G) { const int b = it / NSCH, ch = it % NSCH; const size_t row0 = (size_t)(b * SEQ + ch * SCH);
        f32x4 h = (f32x4){0.f, 0.f, 0.f, 0.f};
#pragma unroll 4
        for (int kk = 0; kk < ch; ++kk) { const f32x4 a = *(const f32x4*)(CARA + (size_t)(b * NSCH + kk) * D + c), hh = *(const f32x4*)(CARH + (size_t)(b * NSCH + kk) * D + c); h = a * h + hh; }
#pragma unroll 8
        for (int t = 0; t < SCH; ++t) { const size_t r = row0 + t; const unsigned gaw = *(const unsigned*)(GT + r * 2048 + gcol), gxw = *(const unsigned*)(GT + r * 2048 + gcol + 128); const u32x2 xcw = *(const u32x2*)(XC + r * D + c);
            f32x4 a, bb; lru_ab4(k0, k1, gaw, gxw, xcw, (ch == 0) && (t == 0), a, bb); h = a * h + bb;
            const u32x2 yw = *(const u32x2*)(P + r * 2048 + c); u32x2 o;
            o.x = cvt_pk_bf16(bflo(yw.x) * h.x, bfhi(yw.x) * h.y); o.y = cvt_pk_bf16(bflo(yw.y) * h.z, bfhi(yw.y) * h.w);
            *(u32x2*)(MIX + r * D + c) = o; } }
}
__device__ __forceinline__ void phase_router(LAS unsigned char* lds, const bf16* X, const float* gain, const float* wr, bf16* H, int* SELP, float* GATE2, int* CC, int bid, int G, int wv) {
    const int tid = tid_laundered(wv), lane = tid & 63, wave = tid >> 6;
    LAS float* wrt = (LAS float*)lds;
    LAS int* sel_e = (LAS int*)(lds + 32768); LAS float* sel_g = (LAS float*)(lds + 32768 + 512);
    for (int idx = tid; idx < 8192; idx += NTHR) { const int c = idx >> 3, e = idx & 7; wrt[e * 1024 + c] = wr[idx]; }
    __syncthreads();
    for (int chunk = bid; chunk < M / 64; chunk += G) {
        for (int i = 0; i < 8; ++i) { const int r = wave * 8 + i, m = chunk * 64 + r;
            const u32x2* xr = (const u32x2*)(X + (size_t)m * D) + lane; f32x4 v[4]; float ss = 0.f;
#pragma unroll
            for (int j = 0; j < 4; ++j) { const u32x2 w = xr[64 * j]; v[j] = (f32x4){bflo(w.x), bfhi(w.x), bflo(w.y), bfhi(w.y)}; ss += (v[j].x * v[j].x + v[j].y * v[j].y) + (v[j].z * v[j].z + v[j].w * v[j].w); }
            const float rstd = 1.0f / sqrtf(wave_sum(ss) * (1.0f / D) + NORM_EPS);
#pragma unroll
            for (int j = 0; j < 4; ++j) { const f32x4 g = *(const f32x4*)(gain + 256 * j + 4 * lane); v[j] = v[j] * rstd * g;
                *(unsigned*)((unsigned char*)H + (size_t)m * D + 256 * j + 4 * lane) = pk4_fp8(v[j].x, v[j].y, v[j].z, v[j].w); }
            float lg[8];
#pragma unroll
            for (int e = 0; e < 8; ++e) { float s = 0.f;
#pragma unroll
                for (int j = 0; j < 4; ++j) { const f32x4 w = *(const LAS f32x4*)(wrt + e * 1024 + 256 * j + 4 * lane); s += (v[j].x * w.x + v[j].y * w.y) + (v[j].z * w.z + v[j].w * w.w); }
                lg[e] = wave_sum(s); }
            int e1 = 0; float l1 = lg[0];
#pragma unroll
            for (int e = 1; e < 8; ++e) if (lg[e] > l1) { l1 = lg[e]; e1 = e; }
            int e2 = (e1 == 0) ? 1 : 0; float l2 = (e1 == 0) ? lg[1] : lg[0];
#pragma unroll
            for (int e = 1; e < 8; ++e) if (e != e1 && lg[e] > l2) { l2 = lg[e]; e2 = e; }
            const float g1 = 1.0f / (1.0f + __expf(l2 - l1)), g2 = 1.0f - g1;
            if (lane == 0) { sel_e[2 * r] = e1; sel_e[2 * r + 1] = e2; sel_g[2 * r] = g1; sel_g[2 * r + 1] = g2; }
        }
        __syncthreads();
        if (wave == 0) { const int ea = sel_e[2 * lane], eb = sel_e[2 * lane + 1]; int pa = 0, pb = 0; const unsigned long long lt = (1ull << lane) - 1ull;
#pragma unroll
            for (int e = 0; e < 8; ++e) { const unsigned long long ma = __ballot(ea == e), mb = __ballot(eb == e); const int ca = __popcll(ma), cb = __popcll(mb);
                if (ea == e) pa = __popcll(ma & lt);
                if (eb == e) pb = ca + __popcll(mb & lt);
                if (lane == e) CC[chunk * 32 + e] = ca + cb; }
            const int tok = chunk * 64 + lane;
            SELP[tok] = ea | (eb << 4) | (pa << 8) | (pb << 16);
            *(f32x2*)(GATE2 + 2 * tok) = (f32x2){sel_g[2 * lane], sel_g[2 * lane + 1]}; }
        __syncthreads();
    }
}
__device__ __forceinline__ void expert_offsets(unsigned* cnt, int (&c)[8], int (&off)[9]) {
    int o = 0;
#pragma unroll
    for (int e = 0; e < 8; ++e) { c[e] = (int)__hip_atomic_load(cnt + e * 64, RLX_AGENT); off[e] = o; o += (c[e] + 255) & ~255; }
    off[8] = o;
}
__device__ __forceinline__ void phase_gather(LAS unsigned char* lds, unsigned* cnt, const int* SELP, const float* GATE2, const int* CC, const bf16* H, unsigned char* HG, float* ROWG, int* CSLOT, int bid, int gw, int NGW, int wv) {
    const int tid = tid_laundered(wv), lane = tid & 63, wave = tid >> 6;
    LAS int* pre = (LAS int*)lds;
    LAS int* tot = (LAS int*)(lds + 8192);
    {
        const int e = wave; int v[4], s = 0;
#pragma unroll
        for (int q = 0; q < 4; ++q) { v[q] = CC[(4 * lane + q) * 32 + e]; s += v[q]; }
        int inc = s;
#pragma unroll
        for (int o = 1; o < 64; o <<= 1) { const int t = shup(inc, o); if (lane >= o) inc += t; }
        int ex = inc - s;
#pragma unroll
        for (int q = 0; q < 4; ++q) { pre[(4 * lane + q) * 8 + e] = ex; ex += v[q]; }
        if (lane == 63) tot[e] = inc;
    }
    __syncthreads();
    int c[8], off[9]; { int o = 0;
#pragma unroll
        for (int e = 0; e < 8; ++e) { c[e] = tot[e]; off[e] = o; o += (c[e] + 255) & ~255; }
        off[8] = o; }
    if (bid == 0 && tid < 8) __hip_atomic_store(cnt + tid * 64, (unsigned)tot[tid], RLX_AGENT);
    for (int m = gw; m < M; m += NGW) { const int sp = SELP[m]; const int ch = m >> 6; const f32x2 g2 = *(const f32x2*)(GATE2 + 2 * m);
        const u32x4 o = ((const u32x4*)((const unsigned char*)H + (size_t)m * D))[lane];
#pragma unroll
        for (int k = 0; k < 2; ++k) { const int e = (sp >> (4 * k)) & 15, rk = (sp >> (8 + 8 * k)) & 255;
            int oe = 0;
#pragma unroll
            for (int q = 0; q < 8; ++q) oe = (q == e) ? off[q] : oe;
            const int r = oe + pre[ch * 8 + e] + rk;
            ((u32x4*)(HG + (size_t)r * D))[lane] = o;
            if (lane == 0) { ROWG[r] = k ? g2.y : g2.x; CSLOT[2 * m + k] = r; } } }
    for (int e = 0; e < 8; ++e) { const int r0 = off[e] + c[e], r1 = off[e + 1];
        for (int r = r0 + gw; r < r1; r += NGW) { ((u32x4*)(HG + (size_t)r * D))[lane] = (u32x4){0u, 0u, 0u, 0u}; if (lane == 0) ROWG[r] = 0.f; } }
}
__device__ __forceinline__ f32x4 moe_row4(const bf16* YB, const float* PART, int s, bool split, int col) {
    if (split && s >= DTAILROW0) { const float* p = PART + (size_t)(s - DTAILROW0) * D + col; f32x4 a = *(const f32x4*)p;
#pragma unroll 1
        for (int k = 1; k < DSPL; ++k) { a = a + *(const f32x4*)(p + (size_t)k * DTAILROWS * D); asm volatile("" : "+v"(a)); }
        return a; }
    const u32x2 w = *(const u32x2*)(YB + (size_t)s * D + col); return (f32x4){bflo(w.x), bfhi(w.x), bflo(w.y), bfhi(w.y)};
}
__device__ __forceinline__ void phase_combine(bf16* X, float* OUT, const bf16* YB, const float* PART, const int* CSLOT, unsigned* cnt, float* PS, bool last, int gw, int NGW, int G, int lane) {
    int c[8], off[9]; expert_offsets(cnt, c, off); const int NP = off[8] / 256; const bool split = (G == 256) && NP >= 128 && NP <= 137;
    for (int m = gw; m < M; m += NGW) { const int s0 = CSLOT[2 * m], s1 = CSLOT[2 * m + 1];
        const u32x2* xr = (const u32x2*)(X + (size_t)m * D) + lane; f32x4 v[4];
#pragma unroll
        for (int j = 0; j < 4; ++j) { const u32x2 w = xr[64 * j]; const f32x4 x = (f32x4){bflo(w.x), bfhi(w.x), bflo(w.y), bfhi(w.y)};
            v[j] = (x + moe_row4(YB, PART, s0, split, 256 * j + 4 * lane)) + moe_row4(YB, PART, s1, split, 256 * j + 4 * lane); }
        if (last) {
#pragma unroll
            for (int j = 0; j < 4; ++j) ((f32x4*)(OUT + (size_t)m * D) + lane)[64 * j] = v[j]; }
        else xb_store(v, X + (size_t)m * D, PS + (size_t)m * 16, lane); }
}

__device__ __forceinline__ int ph_lo_() { const __attribute__((address_space(4))) Args* a = (const __attribute__((address_space(4))) Args*)__builtin_amdgcn_kernarg_segment_ptr(); asm volatile("" : "+s"(a)); return a->ph_lo; }
__device__ __forceinline__ int ph_hi_() { const __attribute__((address_space(4))) Args* a = (const __attribute__((address_space(4))) Args*)__builtin_amdgcn_kernarg_segment_ptr(); asm volatile("" : "+s"(a)); return a->ph_hi; }
constexpr int NPH_PER = 18, NPHASES = 1 + 2 * NPH_PER;
#define PH_BEGIN() const __attribute__((address_space(4))) Args* ap = (const __attribute__((address_space(4))) Args*)__builtin_amdgcn_kernarg_segment_ptr(); asm volatile("" : "+s"(ap)); unsigned char* const ws = ap->ws; (void)ws; const int G = (int)gridDim.x, bid = (int)blockIdx.x; (void)G; (void)bid
#if MK_PER_PHASE
#define GRID_BAR() do { } while (0)
#else
#define GRID_BAR() do { PH_BEGIN(); XcdBarrier b_; b_.bar = (unsigned*)(ws + WS_CTL) + CW_BAR; b_.x = xb_xcc_id(); b_.st = (volatile LAS unsigned*)(lds + MISC_OFF) + 8; xcd_barrier(b_, tid_laundered(wv) == 0); } while (0)
#endif
#if MK_PER_PHASE
#define IN(k) (ph_lo_() <= (k) && (k) < ph_hi_())
#else
#define IN(k) true
#endif
#define SEAM(k) do { if (IN(k) && IN((k) + 1)) GRID_BAR(); } while (0)
#define WAVE_IDS() const int wave = wv_laundered(wv); const int tidl = tid_laundered(wave); const int lane = tidl & 63; const int gw = bid * NWAVES + wave, NGW = G * NWAVES; (void)lane; (void)gw; (void)NGW
template <int jj>
__device__ __forceinline__ void layer_pair(LAS unsigned char* lds, const int wv) {
        const int pb = 1 + NPH_PER * jj;
        REP(0) {
        if (IN(pb + 0)) {
            PH_BEGIN();
            pg8::StaticOrder S; S.init(M / 256, EIN / 256, G, bid, ws + WS_X, (size_t)256 * D * 2, 0, ws + WS_WINE + (size_t)jj * EIN * D * 2, (size_t)256 * D * 2);
            pg8::EpiBf16<0> E{(bf16*)(ws + WS_P), EIN, 0, (const float*)(ws + WS_PS)};
            pg8::gemm_phase<false>(lds, wv, 2 * D, 2 * D, 2 * D, S, E);
            if (G == 256 && bid >= 64) {
                const int wave = wv_laundered(wv), lane = tid_laundered(wave) & 63; LAS unsigned* scr = (LAS unsigned*)(lds + wave * 8192);
                const int gw2 = (bid - 64) * NWAVES + wave, NGW2 = 192 * NWAVES; int cbase2 = 0;
                cvt_class_f8<1>(ap->in[I_MOEG] + (size_t)jj * 8 * D * FF, D, FF, 8, ws + WS_WGUM + (size_t)jj * 8 * 2 * FF * D, (size_t)2 * FF * D, WGU_SCALE, nullptr, gw2, NGW2, scr, lane, cbase2, MOE_DEFER_R0);
                cvt_class_f8<2>(ap->in[I_MOEU] + (size_t)jj * 8 * D * FF, D, FF, 8, ws + WS_WGUM + (size_t)jj * 8 * 2 * FF * D, (size_t)2 * FF * D, WGU_SCALE, nullptr, gw2, NGW2, scr, lane, cbase2, MOE_DEFER_R0);
            }
        }
        SEAM(pb + 0);
        }
        REP(1) {
        if (IN(pb + 1)) { PH_BEGIN();
            phase_attn_conv(lds, (const bf16*)(ws + WS_P), (bf16*)(ws + WS_MIX), ap->in[I_QGAIN] + jj * 64, ap->in[I_KGAIN] + jj * 64, ap->in[I_SINKS] + jj * 8, ap->in[I_HYCONV] + jj * 3 * 512, bid, G, wv); }
        SEAM(pb + 1);
        }
        REP(2) {
        if (IN(pb + 2)) {
            PH_BEGIN();
            pg8::StaticOrder S; S.init(M / 256, D / 256, G, bid, ws + WS_MIX, (size_t)256 * D * 2, 0, ws + WS_WOUTE + (size_t)jj * D * D * 2, (size_t)256 * D * 2);
            pg8::EpiResBf16<FFN_F8(jj) ? 2 : 0, 0> E{(bf16*)(ws + WS_X), ws + WS_H, (float*)(ws + WS_PS)};
            pg8::gemm_phase<false>(lds, wv, 2 * D, 2 * D, 2 * D, S, E);
        }
        SEAM(pb + 2);
        }
        REP(4) {
        if (IN(pb + 4)) {
            PH_BEGIN();
            if constexpr (FFN_F8(jj)) {
            pg8::StaticOrder S; S.init(M / 256, 2 * FF / 256, G, bid, ws + WS_H, (size_t)256 * D, 0, ws + WS_WGU + (size_t)jj * 2 * FF * D * 2, (size_t)256 * D);
            pg8::EpiSwigluF8<WGU_SH, true> E{ws + WS_HID, FF, (const float*)(ws + WS_PS)};
            pg8::gemm_phase<true>(lds, wv, D, D, D, S, E);
            } else {
            pg8::StaticOrder S; S.init(M / 256, 2 * FF / 256, G, bid, ws + WS_X, (size_t)256 * D * 2, 0, ws + WS_WGU + (size_t)jj * 2 * FF * D * 2, (size_t)256 * D * 2);
            if constexpr (FFN_DN_F8(jj)) { pg8::EpiSwigluF8<0, true> E{ws + WS_HID, FF, (const float*)(ws + WS_PS)}; pg8::gemm_phase<false>(lds, wv, 2 * D, 2 * D, 2 * D, S, E); }
            else { pg8::EpiSwiglu E{(bf16*)(ws + WS_HID), FF, (const float*)(ws + WS_PS)}; pg8::gemm_phase<false>(lds, wv, 2 * D, 2 * D, 2 * D, S, E); }
            }
        }
        SEAM(pb + 4);
        }
        REP(5) {
        if (IN(pb + 5)) {
            PH_BEGIN();
            if constexpr (FFN_F8(jj) || FFN_DN_F8(jj)) {
            pg8::StaticOrder S; S.init(M / 256, D / 256, G, bid, ws + WS_HID, (size_t)256 * FF, 0, ws + WS_WDN + (size_t)jj * D * FF * 2, (size_t)256 * FF);
            pg8::EpiResBf16<0, WDN_SH> E{(bf16*)(ws + WS_X), nullptr, (float*)(ws + WS_PS)};
            pg8::gemm_phase<true>(lds, wv, FF, FF, FF, S, E);
            } else {
            pg8::StaticOrder S; S.init(M / 256, D / 256, G, bid, ws + WS_HID, (size_t)256 * FF * 2, 0, ws + WS_WDN + (size_t)jj * D * FF * 2, (size_t)256 * FF * 2);
            pg8::EpiResBf16<0, 0> E{(bf16*)(ws + WS_X), nullptr, (float*)(ws + WS_PS)};
            pg8::gemm_phase<false>(lds, wv, 2 * FF, 2 * FF, 2 * FF, S, E);
            }
        }
        SEAM(pb + 5);
        }
        REP(7) {
        if (IN(pb + 7)) {
            PH_BEGIN();
            pg8::StaticOrder S; S.init(M / 256, 2 * D / 256, G, bid, ws + WS_X, (size_t)256 * D * 2, 0, ws + WS_WINO + (size_t)jj * 2 * D * D * 2, (size_t)256 * D * 2);
            pg8::EpiBf16<1> E{(bf16*)(ws + WS_P), 2 * D, 4, (const float*)(ws + WS_PS)};
            pg8::gemm_phase<false>(lds, wv, 2 * D, 2 * D, 2 * D, S, E);
        }
        SEAM(pb + 7);
        }
        REP(9) {
        if (IN(pb + 9)) {
            PH_BEGIN();
            pg8::StaticOrder S; S.init(M / 256, 8, G, bid, ws + WS_XC, (size_t)256 * D * 2, (size_t)128 * 2, ws + WS_WG + (size_t)jj * 8 * 256 * 128 * 2, (size_t)256 * 128 * 2);
            pg8::EpiF8 E{ws + WS_GT, 2 * D};
            {
                const int tid_c = tid_laundered(wv); pg8::Unit uc;
                for (int i = 0; S.next(i, uc); ++i) conv4_tile((const bf16*)(ws + WS_P), (bf16*)(ws + WS_XC), ap->in[I_RGCONVW] + jj * 4 * D, ap->in[I_RGCONVB] + jj * D, uc.pm, uc.pn, tid_c);
                asm volatile("s_waitcnt vmcnt(0)" ::: "memory"); __syncthreads(); }
            pg8::gemm_phase<false>(lds, wv, 2 * D, 2 * 128, 2 * 128, S, E);
        }
        SEAM(pb + 9);
        }
        REP(10) {
        if (IN(pb + 10)) { PH_BEGIN(); phase_scan1(ws + WS_GT, (const bf16*)(ws + WS_XC), ap->in[I_GAB] + jj * D, ap->in[I_GXB] + jj * D, ap->in[I_LAM] + jj * D, (float*)(ws + WS_CARA), (float*)(ws + WS_CARH), bid, G, wv); }
        SEAM(pb + 10);
        }
        REP(11) {
        if (IN(pb + 11)) { PH_BEGIN(); phase_scan2(ws + WS_GT, (const bf16*)(ws + WS_XC), ap->in[I_GAB] + jj * D, ap->in[I_GXB] + jj * D, ap->in[I_LAM] + jj * D, (const float*)(ws + WS_CARA), (const float*)(ws + WS_CARH), (const bf16*)(ws + WS_P), (bf16*)(ws + WS_MIX), bid, G, wv); }
        SEAM(pb + 11);
        }
        REP(12) {
        if (IN(pb + 12)) {
            PH_BEGIN();
            pg8::StaticOrder S; S.init(M / 256, D / 256, G, bid, ws + WS_MIX, (size_t)256 * D * 2, 0, ws + WS_WOUTO + (size_t)jj * D * D * 2, (size_t)256 * D * 2);
            pg8::EpiResBf16<0, 0> E{(bf16*)(ws + WS_X), nullptr, nullptr};
            pg8::gemm_phase<false>(lds, wv, 2 * D, 2 * D, 2 * D, S, E);
        }
        SEAM(pb + 12);
        }
        REP(13) {
        if (IN(pb + 13)) { PH_BEGIN();
            phase_router(lds, (const bf16*)(ws + WS_X), ap->in[I_NFFN] + (2 * jj + 1) * D, ap->in[I_ROUTER] + jj * D * 8, (bf16*)(ws + WS_H), (int*)(ws + WS_SELP), (float*)(ws + WS_GATE2), (int*)(ws + WS_CC), bid, G, wv); }
        SEAM(pb + 13);
        }
        REP(14) {
        if (IN(pb + 14)) { PH_BEGIN(); WAVE_IDS();
            phase_gather(lds, (unsigned*)(ws + WS_CTL) + CW_CNT + jj * 8 * 64, (const int*)(ws + WS_SELP), (const float*)(ws + WS_GATE2), (const int*)(ws + WS_CC), (const bf16*)(ws + WS_H), ws + WS_HG, (float*)(ws + WS_ROWG), (int*)(ws + WS_CSLOT), bid, gw, NGW, wv); }
        SEAM(pb + 14);
        }
        REP(15) {
        if (IN(pb + 15)) {
            PH_BEGIN();
            int c[8], off[9]; expert_offsets((unsigned*)(ws + WS_CTL) + CW_CNT + jj * 8 * 64, c, off);
            pg8::GroupOrder S; S.nM = __builtin_amdgcn_readfirstlane(off[8] / 256); S.nN = 2 * FF / 256; S.nwg = S.nM * S.nN; S.G = G; S.c = bid;
#pragma unroll
            for (int e = 0; e < 8; ++e) S.cum[e] = __builtin_amdgcn_readfirstlane(off[e + 1] / 256);
            S.A = (const char*)(ws + WS_HG); S.a_pm = (size_t)256 * D; S.B = (const char*)(ws + WS_WGUM + (size_t)jj * 8 * 2 * FF * D); S.b_pn = (size_t)256 * D; S.b_e = (size_t)2 * FF * D;
            pg8::EpiSwigluF8<WGU_SH, false> E{ws + WS_HID, FF, nullptr};
            pg8::gemm_phase<true>(lds, wv, D, D, D, S, E);
        }
        SEAM(pb + 15);
        }
        REP(16) {
        if (IN(pb + 16)) {
            PH_BEGIN();
            int c[8], off[9]; expert_offsets((unsigned*)(ws + WS_CTL) + CW_CNT + jj * 8 * 64, c, off);
            pg8::DownOrder S; S.NP = __builtin_amdgcn_readfirstlane(off[8] / 256); S.G = G; S.c = bid;
            S.split = (G == 256) && S.NP >= 128 && S.NP <= 137; S.TU = (S.NP - 128) * 4;
#pragma unroll
            for (int e = 0; e < 8; ++e) S.cum[e] = __builtin_amdgcn_readfirstlane(off[e + 1] / 256);
            S.A = (const char*)(ws + WS_HID); S.a_pm = (size_t)256 * FF; S.B = (const char*)(ws + WS_WDNM + (size_t)jj * 8 * D * FF); S.b_pn = (size_t)256 * FF; S.b_e = (size_t)D * FF;
            pg8::EpiMoeDown E{(bf16*)(ws + WS_YB), (float*)(ws + WS_PART), (const float*)(ws + WS_ROWG)};
            pg8::gemm_phase<true>(lds, wv, FF, FF, FF, S, E);
        }
        SEAM(pb + 16);
        }
        REP(17) {
        if (IN(pb + 17)) { PH_BEGIN(); WAVE_IDS();
            phase_combine((bf16*)(ws + WS_X), ap->out, (const bf16*)(ws + WS_YB), (const float*)(ws + WS_PART), (const int*)(ws + WS_CSLOT), (unsigned*)(ws + WS_CTL) + CW_CNT + jj * 8 * 64, (float*)(ws + WS_PS), jj == 1, gw, NGW, G, lane); }
        if (jj == 0) SEAM(pb + 17);
        }
}
__global__ void __launch_bounds__(NTHR, 2) mega_fwd(Args args) {
    extern __shared__ __attribute__((aligned(16))) unsigned char lds_raw[];
    LAS unsigned char* lds = (LAS unsigned char*)lds_raw;
    const int tid = threadIdx.x; const int wv = __builtin_amdgcn_readfirstlane(tid >> 6);
    for (int u = tid; u < (LDS_BYTES - LDSCTL_OFF) / 4; u += NTHR) ((LAS unsigned*)(lds + LDSCTL_OFF))[u] = 0u;
    __syncthreads();
#if !MK_PER_PHASE
    (void)xcd_barrier_post((unsigned*)(args.ws + WS_CTL) + CW_BAR, (volatile LAS unsigned*)(lds + MISC_OFF) + 8, tid == 0);
#endif

    REP(18) {
    if (IN(0)) {
        PH_BEGIN(); WAVE_IDS();
        LAS unsigned* scr = (LAS unsigned*)(lds + wave * 8192); int cbase = 0;
        cvt_class<0>(ap->in[I_HYWIN], D, EIN, 2, (bf16*)(ws + WS_WINE), (size_t)EIN * D, ap->in[I_NMIX], 2 * D, gw, NGW, scr, lane, cbase);
        cvt_class<0>(ap->in[I_HYWOUT], D, D, 2, (bf16*)(ws + WS_WOUTE), (size_t)D * D, nullptr, 0, gw, NGW, scr, lane, cbase);
        cvt_class<0>(ap->in[I_RGWIN], D, 2 * D, 2, (bf16*)(ws + WS_WINO), (size_t)2 * D * D, ap->in[I_NMIX] + D, 2 * D, gw, NGW, scr, lane, cbase);
        cvt_class<0>(ap->in[I_RGWOUT], D, D, 2, (bf16*)(ws + WS_WOUTO), (size_t)D * D, nullptr, 0, gw, NGW, scr, lane, cbase);
        cvt_class<0>(ap->in[I_GAW], 128, 128, 16, (bf16*)(ws + WS_WG), (size_t)256 * 128, nullptr, 0, gw, NGW, scr, lane, cbase);
        cvt_class<0>(ap->in[I_GXW], 128, 128, 16, (bf16*)(ws + WS_WG) + 128 * 128, (size_t)256 * 128, nullptr, 0, gw, NGW, scr, lane, cbase);
#pragma unroll
        for (int j2 = 0; j2 < 2; ++j2) {
            if (FFN_F8(j2)) {
                cvt_class_f8<1>(ap->in[I_FFNG] + (size_t)j2 * D * FF, D, FF, 1, ws + WS_WGU + (size_t)j2 * 2 * FF * D * 2, 0, WGU_SCALE, ap->in[I_NFFN] + 2 * j2 * D, gw, NGW, scr, lane, cbase);
                cvt_class_f8<2>(ap->in[I_FFNU] + (size_t)j2 * D * FF, D, FF, 1, ws + WS_WGU + (size_t)j2 * 2 * FF * D * 2, 0, WGU_SCALE, ap->in[I_NFFN] + 2 * j2 * D, gw, NGW, scr, lane, cbase);
                cvt_class_f8<0>(ap->in[I_FFND] + (size_t)j2 * D * FF, FF, D, 1, ws + WS_WDN + (size_t)j2 * D * FF * 2, 0, WDN_SCALE, nullptr, gw, NGW, scr, lane, cbase);
            } else {
                cvt_class<1>(ap->in[I_FFNG] + (size_t)j2 * D * FF, D, FF, 1, (bf16*)(ws + WS_WGU) + (size_t)j2 * 2 * FF * D, 0, ap->in[I_NFFN] + 2 * j2 * D, 0, gw, NGW, scr, lane, cbase);
                cvt_class<2>(ap->in[I_FFNU] + (size_t)j2 * D * FF, D, FF, 1, (bf16*)(ws + WS_WGU) + (size_t)j2 * 2 * FF * D, 0, ap->in[I_NFFN] + 2 * j2 * D, 0, gw, NGW, scr, lane, cbase);
                if (FFN_DN_F8(j2)) cvt_class_f8<0>(ap->in[I_FFND] + (size_t)j2 * D * FF, FF, D, 1, ws + WS_WDN + (size_t)j2 * D * FF * 2, 0, WDN_SCALE, nullptr, gw, NGW, scr, lane, cbase);
                else cvt_class<0>(ap->in[I_FFND] + (size_t)j2 * D * FF, FF, D, 1, (bf16*)(ws + WS_WDN) + (size_t)j2 * D * FF, 0, nullptr, 0, gw, NGW, scr, lane, cbase);
            } }
        const int r_hi = (G == 256) ? MOE_DEFER_R0 : (1 << 30);
        cvt_class_f8<1>(ap->in[I_MOEG], D, FF, 16, ws + WS_WGUM, (size_t)2 * FF * D, WGU_SCALE, nullptr, gw, NGW, scr, lane, cbase, 0, r_hi);
        cvt_class_f8<2>(ap->in[I_MOEU], D, FF, 16, ws + WS_WGUM, (size_t)2 * FF * D, WGU_SCALE, nullptr, gw, NGW, scr, lane, cbase, 0, r_hi);
        cvt_class_f8<0>(ap->in[I_MOED], FF, D, 16, ws + WS_WDNM, (size_t)D * FF, WDN_SCALE, nullptr, gw, NGW, scr, lane, cbase);
        phase_xb(ap->in[I_X], (bf16*)(ws + WS_X), (float*)(ws + WS_PS), gw, NGW, lane);
    }
    SEAM(0);
    }

    layer_pair<0>(lds, wv);
    layer_pair<1>(lds, wv);
#undef IN
#undef SEAM
#undef GRID_BAR
#undef WAVE_IDS
}

extern "C" void kernel_launch(void* const* d_in, const int* in_sizes, int n_in, void* d_out, int out_size, void* d_ws, size_t ws_size, hipStream_t stream) {
    static int grid = 0;
    if (grid == 0) {
        if (n_in != 25 || in_sizes[0] != M * D || out_size != M * D || ws_size < WS_END) { fprintf(stderr, "kernel_launch: unexpected shapes (n_in %d, ws %zu)\n", n_in, ws_size); grid = -1; return; }
        int dev = 0, cus = 0, per_cu = 0;
        if (hipGetDevice(&dev) != hipSuccess || hipDeviceGetAttribute(&cus, hipDeviceAttributeMultiprocessorCount, dev) != hipSuccess) { grid = -1; return; }
        if (hipFuncSetAttribute((const void*)mega_fwd, hipFuncAttributeMaxDynamicSharedMemorySize, LDS_BYTES) != hipSuccess) { fprintf(stderr, "kernel_launch: hipFuncSetAttribute failed\n"); grid = -1; return; }
        if (hipOccupancyMaxActiveBlocksPerMultiprocessor(&per_cu, (const void*)mega_fwd, NTHR, LDS_BYTES) != hipSuccess || per_cu < 1) { fprintf(stderr, "kernel_launch: occupancy query says %d\n", per_cu); }
        (void)hipGetLastError();
        grid = cus;
    }
    if (grid < 0) return;
    if (hipMemsetAsync((char*)d_ws + WS_CTL, 0, CTL_ZERO_BYTES, stream) != hipSuccess) return;
    Args a{};
    for (int i = 0; i < 25; ++i) a.in[i] = (const float*)d_in[i];
    a.out = (float*)d_out; a.ws = (unsigned char*)d_ws;
#if MK_PER_PHASE
    for (int p = 0; p < NPHASES; ++p) { a.ph_lo = p; a.ph_hi = p + 1; hipLaunchKernelGGL(mega_fwd, dim3(grid), dim3(NTHR), LDS_BYTES, stream, a); }
#else
    a.ph_lo = 0; a.ph_hi = NPHASES;
    hipLaunchKernelGGL(mega_fwd, dim3(grid), dim3(NTHR), LDS_BYTES, stream, a);
#endif
}
```

```cpp
#include <hip/hip_runtime.h>
#include <cstdio>
#include <cstdint>

#ifndef MK_PER_PHASE
#define MK_PER_PHASE 0
#endif

#ifndef PROBE_DUP
#define PROBE_DUP 0u
#endif
#define REP(k) _Pragma("unroll 1") for (int rep_ = 0; rep_ < (int)((PROBE_DUP >> (k)) & 1u) + 1; ++rep_)
#define LAS __attribute__((address_space(3)))
#define GAS __attribute__((address_space(1)))
typedef unsigned short bf16;
typedef short bf16x8 __attribute__((ext_vector_type(8)));
typedef float f32x4 __attribute__((ext_vector_type(4)));
typedef float f32x2 __attribute__((ext_vector_type(2)));
typedef unsigned u32x4 __attribute__((ext_vector_type(4)));
typedef unsigned u32x2 __attribute__((ext_vector_type(2)));
typedef int i32x4 __attribute__((ext_vector_type(4)));
typedef int i32x8 __attribute__((ext_vector_type(8)));

constexpr int D = 1024, BATCH = 8, SEQ = 2048, M = BATCH * SEQ;
constexpr int EIN = 2304, FF = 3584, NE = 8, ECAP = 16384;
constexpr int MAXROWS = 34816;
constexpr int NWAVES = 8, NTHR = 512;
constexpr float NORM_EPS = 1e-6f;
#define FFN_F8(j) ((j) == 1)
#define FFN_DN_F8(j) (true)
constexpr int WGU_SH = 5, WDN_SH = 7; constexpr float WGU_SCALE = (float)(1 << WGU_SH), WDN_SCALE = (float)(1 << WDN_SH);
constexpr int MOE_DEFER_R0 = 800;
constexpr int DSPL = 7, DTAILROW0 = 32768, DTAILROWS = 2304;
constexpr int SCH = 32, NSCH = SEQ / SCH;

constexpr size_t MiB = 1u << 20;
constexpr size_t WS_CTL = 0, CTL_ZERO_BYTES = 1 * MiB;
constexpr size_t WS_SELP = 1 * MiB;
constexpr size_t WS_GATE2 = WS_SELP + 128 * 1024;
constexpr size_t WS_CC = WS_SELP + 512 * 1024;
constexpr size_t WS_CSLOT = 2 * MiB;
constexpr size_t WS_ROWG = WS_CSLOT + 256 * 1024;
constexpr size_t WS_CARA = 836 * MiB;
constexpr size_t WS_CARH = 838 * MiB;
constexpr size_t WS_WINE = 5 * MiB;
constexpr size_t WS_WOUTE = 14 * MiB;
constexpr size_t WS_WINO = 18 * MiB;
constexpr size_t WS_WOUTO = 26 * MiB;
constexpr size_t WS_WG = 30 * MiB;
constexpr size_t WS_WGU = 31 * MiB;
constexpr size_t WS_WDN = 59 * MiB;
constexpr size_t WS_WGUM = 73 * MiB;
constexpr size_t WS_WDNM = 297 * MiB;
constexpr size_t WS_H = 409 * MiB;
constexpr size_t WS_U = 441 * MiB;
constexpr size_t WS_P = WS_U;
constexpr size_t WS_MIX = WS_U + 72 * MiB;
constexpr size_t WS_XC = WS_U + 104 * MiB;
constexpr size_t WS_GT = WS_U + 136 * MiB;
constexpr size_t WS_HID = WS_U;
constexpr size_t WS_YB = 705 * MiB;
constexpr size_t WS_PART = 773 * MiB;
constexpr size_t WS_HG = WS_YB;
constexpr size_t WS_PS = 841 * MiB;
constexpr size_t WS_X = 842 * MiB;
constexpr size_t WS_END = 874 * MiB;
static_assert(WS_PART + (size_t)DSPL * DTAILROWS * D * 4 <= WS_PS && WS_YB + (size_t)MAXROWS * D * 2 <= WS_PART && (size_t)MAXROWS * FF * 2 <= 264 * MiB && WS_GT + 64 * MiB <= WS_U + 264 * MiB && WS_U + 264 * MiB == WS_YB, "ws map");
constexpr int CW_BAR = 4096;
constexpr int CW_CNT = 16384;

constexpr int RING_BYTES = 131072;
constexpr int LDSCTL_OFF = RING_BYTES, MISC_OFF = LDSCTL_OFF + 320;
constexpr int LDS_BYTES = 147456;
constexpr int RS_OFF = LDSCTL_OFF + 4096;

#define RLX_AGENT __ATOMIC_RELAXED, __HIP_MEMORY_SCOPE_AGENT
#define LDS_WAIT() asm volatile("s_waitcnt lgkmcnt(0)" ::: "memory")
#define VM_WAIT() asm volatile("s_waitcnt vmcnt(0)" ::: "memory")
__device__ __forceinline__ unsigned cvt_pk_bf16(float lo, float hi) { unsigned r; asm volatile("v_cvt_pk_bf16_f32 %0, %1, %2" : "=v"(r) : "v"(lo), "v"(hi)); return r; }
__device__ __forceinline__ unsigned pk4_fp8(float a, float b, float c, float d) { int w = 0; w = __builtin_amdgcn_cvt_pk_fp8_f32(a, b, w, false); w = __builtin_amdgcn_cvt_pk_fp8_f32(c, d, w, true); return (unsigned)w; }
__device__ __forceinline__ float bflo(unsigned w) { return __uint_as_float(w << 16); }
__device__ __forceinline__ float bfhi(unsigned w) { return __uint_as_float(w & 0xffff0000u); }
__device__ __forceinline__ int lane_v() { int l; asm volatile("v_mbcnt_lo_u32_b32 %0, -1, 0\n\tv_mbcnt_hi_u32_b32 %0, -1, %0" : "=v"(l)); return l; }
__device__ __forceinline__ float shx(float v, int m) { return __int_as_float(__builtin_amdgcn_ds_bpermute((lane_v() ^ m) << 2, __float_as_int(v))); }
__device__ __forceinline__ int shup(int v, int o) { const int l = lane_v(); const int t = __builtin_amdgcn_ds_bpermute(((l - o) & 63) << 2, v); return (l >= o) ? t : v; }
__device__ __forceinline__ float wave_sum(float v) {
#pragma unroll
    for (int o = 1; o < 64; o <<= 1) v += shx(v, o);
    return v;
}
__device__ __forceinline__ int wv_laundered(int wv) { asm volatile("" : "+s"(wv)); return wv; }
__device__ __forceinline__ int tid_laundered(int wv) { int l; asm volatile("v_mbcnt_lo_u32_b32 %0, -1, 0\n\tv_mbcnt_hi_u32_b32 %0, -1, %0" : "=v"(l)); return wv * 64 + l; }
__device__ __forceinline__ float fast_rcp(float x) { return __builtin_amdgcn_rcpf(x); }
__device__ __forceinline__ float fast_exp(float x) { return __builtin_amdgcn_exp2f(x * 1.4426950408889634f); }
__device__ __forceinline__ float sigmoidf_(float x) { return fast_rcp(1.0f + fast_exp(-x)); }
__device__ __forceinline__ float gelu_tanh(float v) { const float u = 1.5957691216057308f * (v + 0.044715f * v * v * v); return v * sigmoidf_(u); }
__device__ __forceinline__ float siluf_(float v) { return v * sigmoidf_(v); }

#define XB_TMO      128
#define XB_XCNT(j)  (256  + 64 * (j))
#define XB_XSUB(j)  (1280 + 64 * (j))
#define XB_XGEN(j)  (2304 + 64 * (j))
#define XB_TOP      3328
#define XB_TOPGEN   3392
#define XCD_BAR_WORDS 3456
#define XB_SPIN_CAP (1u << 22)

__device__ __forceinline__ unsigned xb_ld(unsigned* p)              { return __hip_atomic_load(p, __ATOMIC_RELAXED, __HIP_MEMORY_SCOPE_AGENT); }
__device__ __forceinline__ unsigned xb_add(unsigned* p, unsigned v) { return __hip_atomic_fetch_add(p, v, __ATOMIC_RELAXED, __HIP_MEMORY_SCOPE_AGENT); }
__device__ __forceinline__ unsigned xb_xcc_id() { return (unsigned)__builtin_amdgcn_s_getreg((3 << 11) | 20) & 0xFu; }
#define XB_SPIN(cond, bar) do { unsigned _sp = 0; while (cond) { __builtin_amdgcn_s_sleep(1); \
    if ((++_sp & 255u) == 0u) { if (xb_ld(&(bar)[XB_TMO])) break; if (_sp > XB_SPIN_CAP) { atomicAdd(&(bar)[XB_TMO], 1u); break; } } } } while (0)

struct XcdBarrier { unsigned* bar; unsigned x; volatile LAS unsigned* st; };

__device__ __forceinline__ XcdBarrier xcd_barrier_post(unsigned* bar, volatile LAS unsigned* st, bool leader) {
    XcdBarrier b; b.bar = bar; b.x = xb_xcc_id(); b.st = st;
    if (leader) (void)xb_add(&bar[XB_XCNT(b.x)], 1u);
    return b;
}
__device__ __forceinline__ void xcd_barrier_complete(unsigned* bar, unsigned x, unsigned& nloc, unsigned& nx) {
    const unsigned G = gridDim.x * gridDim.y * gridDim.z;
    unsigned sum, cnt, mine, sp = 0u;
    for (;;) {
        sum = 0u; cnt = 0u; mine = 0u;
#pragma unroll
        for (unsigned j = 0; j < 16; ++j) { const unsigned c = xb_ld(&bar[XB_XCNT(j)]); sum += c; cnt += (c > 0u) ? 1u : 0u; mine = (j == x) ? c : mine; }
        if (sum == G) break;
        __builtin_amdgcn_s_sleep(1);
        if ((++sp & 255u) == 0u) { if (xb_ld(&bar[XB_TMO])) break; if (sp > XB_SPIN_CAP) { atomicAdd(&bar[XB_TMO], 1u); break; } }
    }
    nloc = mine > 0u ? mine : 1u; nx = cnt > 0u ? cnt : 1u;
}
__device__ __forceinline__ void xcd_barrier(const XcdBarrier& b, bool leader) {
    asm volatile("s_waitcnt vmcnt(0)" ::: "memory");
    __syncthreads();
    if (leader) {
        unsigned* bar = b.bar;
        __builtin_amdgcn_s_waitcnt(0);
        unsigned nloc = b.st[0], nx = b.st[1];
        if (nloc == 0u) { xcd_barrier_complete(bar, b.x, nloc, nx); b.st[0] = nloc; b.st[1] = nx; }
        const unsigned old = xb_add(&bar[XB_XSUB(b.x)], 1u);
        const unsigned gen = old / nloc;
        if (old + 1u == (gen + 1u) * nloc) {
            __builtin_amdgcn_fence(__ATOMIC_RELEASE, "agent");
            asm volatile("s_waitcnt vmcnt(0)" ::: "memory");
            const unsigned og = xb_add(&bar[XB_TOP], 1u);
            const unsigned tg = og / nx;
            if (og + 1u == (tg + 1u) * nx) xb_add(&bar[XB_TOPGEN], 1u);
            else XB_SPIN(xb_ld(&bar[XB_TOPGEN]) == tg, bar);
            __builtin_amdgcn_fence(__ATOMIC_ACQUIRE, "agent");
            xb_add(&bar[XB_XGEN(b.x)], 1u);
            asm volatile("s_waitcnt vmcnt(0)" ::: "memory");
        } else {
            __builtin_amdgcn_fence(__ATOMIC_ACQUIRE, "agent");
            XB_SPIN(xb_ld(&bar[XB_XGEN(b.x)]) == gen, bar);
            asm volatile("s_waitcnt vmcnt(0)" ::: "memory");
        }
    }
    __syncthreads();
}

namespace pg8 {
constexpr int BM = 256, BK = 64, HALF = 128, HTB = HALF * BK * 2, STAGE_BYTES = 8 * HTB, NXCD = 8, WGM = 8;
__host__ __device__ __forceinline__ int lds_byte(int r, int c) { const int st = (r >> 4) * 2 + (c >> 5), rr = r & 15, cc = c & 31, ob = rr * 64 + cc * 2; return st * 1024 + (ob ^ (((ob >> 9) & 1) << 5)); }
__host__ __device__ __forceinline__ void stage_rc(int b, int& R, int& C) { const int st = b / 1024, sb = b % 1024, swz = sb ^ (((sb >> 9) & 1) << 5); R = (st >> 1) * 16 + swz / 64; C = (st & 1) * 32 + (swz % 64) / 2; }
__host__ __device__ __forceinline__ int perm32(int rho) { const int n = rho >> 4, i = rho & 15; return 8 * (i >> 2) + 4 * n + (i & 3); }

struct Unit { int pm, pn, ks; };

struct StaticOrder {
    int nM, nN, nwg, G, c;
    const char* A; const char* B; size_t a_pm, a_pn, b_pn;
    __device__ __forceinline__ void init(int nM_, int nN_, int G_, int c_, const void* A_, size_t a_pm_, size_t a_pn_, const void* B_, size_t b_pn_) {
        nM = nM_; nN = nN_; nwg = nM * nN; G = G_; c = c_; A = (const char*)A_; B = (const char*)B_; a_pm = a_pm_; a_pn = a_pn_; b_pn = b_pn_; }
    __device__ __forceinline__ bool next(int i, Unit& u) const {
        const long L = (long)i * G + c; if (L >= nwg) return false;
        int wgid = (int)L; { const int q = nwg / NXCD, r = nwg % NXCD, xcd = wgid % NXCD, off = wgid / NXCD; wgid = (xcd < r ? xcd * (q + 1) : r * (q + 1) + (xcd - r) * q) + off; }
        const int nig = WGM * nN, gid = wgid / nig, fm = gid * WGM, gsz = (nM - fm) < WGM ? (nM - fm) : WGM;
        u.pm = __builtin_amdgcn_readfirstlane(fm + ((wgid % nig) % gsz)); u.pn = __builtin_amdgcn_readfirstlane((wgid % nig) / gsz); u.ks = -1; return true;
    }
    __device__ __forceinline__ const char* a_ptr(const Unit& u) const { return A + (size_t)u.pm * a_pm + (size_t)u.pn * a_pn; }
    __device__ __forceinline__ const char* b_ptr(const Unit& u) const { return B + (size_t)u.pn * b_pn; }
    __device__ __forceinline__ int unit_nt(const Unit&, int nt) const { return nt; }
};
struct GroupOrder {
    int nM, nN, nwg, G, c; int cum[8];
    const char* A; const char* B; size_t a_pm, b_pn, b_e;
    __device__ __forceinline__ bool next(int i, Unit& u) const {
        const long L = (long)i * G + c; if (L >= nwg) return false;
        int wgid = (int)L; { const int q = nwg / NXCD, r = nwg % NXCD, xcd = wgid % NXCD, off = wgid / NXCD; wgid = (xcd < r ? xcd * (q + 1) : r * (q + 1) + (xcd - r) * q) + off; }
        const int nig = WGM * nN, gid = wgid / nig, fm = gid * WGM, gsz = (nM - fm) < WGM ? (nM - fm) : WGM;
        u.pm = __builtin_amdgcn_readfirstlane(fm + ((wgid % nig) % gsz)); u.pn = __builtin_amdgcn_readfirstlane((wgid % nig) / gsz); u.ks = -1; return true;
    }
    __device__ __forceinline__ const char* a_ptr(const Unit& u) const { return A + (size_t)u.pm * a_pm; }
    __device__ __forceinline__ const char* b_ptr(const Unit& u) const {
        const int e = __builtin_amdgcn_readfirstlane((u.pm >= cum[0]) + (u.pm >= cum[1]) + (u.pm >= cum[2]) + (u.pm >= cum[3]) + (u.pm >= cum[4]) + (u.pm >= cum[5]) + (u.pm >= cum[6]));
        return B + (size_t)e * b_e + (size_t)u.pn * b_pn; }
    __device__ __forceinline__ int unit_nt(const Unit&, int nt) const { return nt; }
};
struct DownOrder {
    int NP, G, c, TU; bool split; int cum[8];
    const char* A; const char* B; size_t a_pm, b_pn, b_e;
    __device__ __forceinline__ bool next(int i, Unit& u) const {
        if (split) {
            if (i < 2) { const int x = c & 7, l = i * 32 + (c >> 3); u.pm = __builtin_amdgcn_readfirstlane(x + 8 * (l >> 2)); u.pn = __builtin_amdgcn_readfirstlane(l & 3); u.ks = -1; return true; }
            if (i == 2 && c < TU * DSPL) { const int j = c / DSPL; u.pm = __builtin_amdgcn_readfirstlane(128 + (j >> 2)); u.pn = __builtin_amdgcn_readfirstlane(j & 3); u.ks = __builtin_amdgcn_readfirstlane(c - DSPL * j); return true; }
            return false;
        }
        const long L = (long)i * G + c; if (L >= (long)NP * 4) return false;
        u.pm = __builtin_amdgcn_readfirstlane((int)(L >> 2)); u.pn = __builtin_amdgcn_readfirstlane((int)(L & 3)); u.ks = -1; return true;
    }
    __device__ __forceinline__ size_t koff(const Unit& u) const { return u.ks > 0 ? (size_t)u.ks * (FF / DSPL) : 0; }
    __device__ __forceinline__ const char* a_ptr(const Unit& u) const { return A + (size_t)u.pm * a_pm + koff(u); }
    __device__ __forceinline__ const char* b_ptr(const Unit& u) const {
        const int e = __builtin_amdgcn_readfirstlane((u.pm >= cum[0]) + (u.pm >= cum[1]) + (u.pm >= cum[2]) + (u.pm >= cum[3]) + (u.pm >= cum[4]) + (u.pm >= cum[5]) + (u.pm >= cum[6]));
        return B + (size_t)e * b_e + (size_t)u.pn * b_pn + koff(u); }
    __device__ __forceinline__ int unit_nt(const Unit& u, int nt) const { return u.ks >= 0 ? (FF / DSPL) / 128 : nt; }
};

typedef f32x4 Acc[2][2][4][2];
__device__ __forceinline__ const char* uni_ptr(const char* p) {
    const unsigned long long v = (unsigned long long)p; const unsigned lo = __builtin_amdgcn_readfirstlane((unsigned)v), hi = __builtin_amdgcn_readfirstlane((unsigned)(v >> 32));
    return (const char*)(((unsigned long long)hi << 32) | lo); }
template <int OFF, int LOFF>
__device__ __forceinline__ void glds16s(const char* sbase, unsigned voff, unsigned lds_base) {
    asm volatile("s_add_u32 m0, %2, %4\n\ts_nop 0\n\tglobal_load_lds_dwordx4 %0, %1 offset:%3" :: "v"(voff), "s"(sbase), "s"(lds_base), "n"(OFF), "n"(LOFF - OFF) : "memory", "scc");
}

template <class Epi> __device__ __forceinline__ constexpr int mxs_() { return 0x01010101 * (127 - Epi::MXSH); }
template <bool FP8, class Epi, class Sched>
__device__ __forceinline__ void gemm_phase(LAS unsigned char* lds, const int wv, const int ldaB, const int ldbB, const int KB, const Sched S, const Epi E) {
    const int wid = wv_laundered(wv), tid = tid_laundered(wid), lane = tid & 63, wr = wid >> 2, wc = wid & 3, fr = lane & 15, fq = lane >> 4;
    int nt = KB / 128; asm volatile("" : "+s"(nt));
    unsigned voffA[2], voffB[2];
#pragma unroll
    for (int i = 0; i < 2; ++i) { int R, C; stage_rc(tid * 16 + i * 8192, R, C); const int Rb = Epi::PERM ? ((R & ~31) + perm32(R & 31)) : R;
        voffA[i] = (unsigned)(R * ldaB + 2 * C); voffB[i] = (unsigned)(Rb * ldbB + 2 * C); }
    const size_t kstep = (size_t)(BK * 2);
    const size_t hstepA = (size_t)HALF * ldaB, hstepB = (size_t)HALF * ldbB;
    const unsigned ldsb = (unsigned)(size_t)lds + (unsigned)wid * 1024u;
    const int aoff = lds_byte(wr * 64 + fr, fq * 8);
    int boff = lds_byte(wc * 32 + fr, fq * 8) + 4 * HTB; asm volatile("" : "+v"(boff));
#define PG8_SA(b, h) (((b) * 2 + (h)) * HTB)
#define PG8_SB(b, h) ((4 + (b) * 2 + (h)) * HTB)
#define PG8_STAGE(bufoff, gbase, voff) do { glds16s<0, (bufoff)>((const char*)(gbase), (voff)[0], ldsb); glds16s<0, (bufoff) + 8192>((const char*)(gbase), (voff)[1], ldsb); } while (0)
#define PG8_STAGE1(bufoff, gbase, voff) do { glds16s<BK * 2, (bufoff)>((const char*)(gbase), (voff)[0], ldsb); glds16s<BK * 2, (bufoff) + 8192>((const char*)(gbase), (voff)[1], ldsb); } while (0)
#define PG8_LD2(dst, dst8, off) do { if constexpr (FP8) { const i32x4 lo_ = *(const LAS i32x4*)(lds + (off)), hi_ = *(const LAS i32x4*)(lds + (off) + 1024); dst8 = __builtin_shufflevector(lo_, hi_, 0, 1, 2, 3, 4, 5, 6, 7); } \
        else { dst[0] = *(const LAS bf16x8*)(lds + (off)); dst[1] = *(const LAS bf16x8*)(lds + (off) + 1024); } } while (0)
#define PG8_LDA(dst, b, h) do { const int aoff_ = aoff;   \
        _Pragma("unroll") for (int m = 0; m < 4; ++m) PG8_LD2(dst[m], dst##8[m], PG8_SA(b, h) + aoff_ + m * 2048); } while (0)
#define PG8_LDB(dst, b, h) do { _Pragma("unroll") for (int n = 0; n < 2; ++n) PG8_LD2(dst[n], dst##8[n], PG8_SB(b, h) - 4 * HTB + boff + n * 2048); } while (0)
#define PG8_MMA(ai, bj, At, Bt, Z) do { __builtin_amdgcn_s_setprio(1); _Pragma("unroll") for (int m = 0; m < 4; ++m) _Pragma("unroll") for (int n = 0; n < 2; ++n) { \
        const f32x4 c0_ = (Z) ? (f32x4){0.f, 0.f, 0.f, 0.f} : acc[ai][bj][m][n];     \
        if constexpr (FP8) acc[ai][bj][m][n] = __builtin_amdgcn_mfma_scale_f32_16x16x128_f8f6f4(Bt##8[n], At##8[m], c0_, 0, 0, 0, mxs_<Epi>(), 0, 0x7f7f7f7f); \
        else { acc[ai][bj][m][n] = __builtin_amdgcn_mfma_f32_16x16x32_bf16(Bt[n][0], At[m][0], c0_, 0, 0, 0); acc[ai][bj][m][n] = __builtin_amdgcn_mfma_f32_16x16x32_bf16(Bt[n][1], At[m][1], acc[ai][bj][m][n], 0, 0, 0); } } __builtin_amdgcn_s_setprio(0); } while (0)
#define PG8_WAIT_V(n) asm volatile("s_waitcnt vmcnt(" #n ")" ::: "memory")
#define PG8_WAIT_L(n) asm volatile("s_waitcnt lgkmcnt(" #n ")" ::: "memory")
#define PG8_BAR __builtin_amdgcn_s_barrier()
#define PG8_SCHED __builtin_amdgcn_sched_barrier(0)
    Unit cur, nxt; int ui = 0;
    if (!S.next(0, cur)) return;
    int ntc = S.unit_nt(cur, nt);
    Acc acc;
    const LAS float* rsl = (const LAS float*)(lds + RS_OFF);
#define PG8_RS_ISSUE(pm_) do { const int t_ = tid_laundered(wid); if constexpr (Epi::RSGATE) { if (t_ < 256) rp0.x = E.rowg[(pm_) * BM + t_]; }     \
        else { const float* pp_ = E.ps + ((size_t)(2 * (t_ & 1)) * M + (size_t)((pm_) * BM + (t_ >> 1))) * 4; rp0 = *(const f32x4*)pp_; rp1 = *(const f32x4*)(pp_ + (size_t)M * 4); } } while (0)
#define PG8_RS_COMMIT(slot_) do { const int t_ = tid_laundered(wid); if constexpr (Epi::RSGATE) { if (t_ < 256) ((LAS float*)(lds + RS_OFF))[(slot_) * 256 + t_] = rp0.x; } \
        else { float s_ = ((rp0.x + rp0.y) + (rp0.z + rp0.w)) + ((rp1.x + rp1.y) + (rp1.z + rp1.w)); s_ += shx(s_, 1); \
        if ((t_ & 1) == 0) ((LAS float*)(lds + RS_OFF))[(slot_) * 256 + (t_ >> 1)] = __builtin_amdgcn_rsqf(s_ * (1.0f / D) + NORM_EPS); } } while (0)
    f32x4 rp0, rp1;
    if constexpr (Epi::LDSRS) { PG8_RS_ISSUE(cur.pm); PG8_RS_COMMIT(0); }
    bf16x8 At[4][2], B0[2][2], B1[2][2]; i32x8 At8[4], B08[2], B18[2];
    const char* cA = S.a_ptr(cur); const char* cB = S.b_ptr(cur);
    PG8_STAGE(PG8_SB(0, 0), cB, voffB); PG8_STAGE(PG8_SB(0, 1), cB + hstepB, voffB); PG8_STAGE(PG8_SA(0, 0), cA, voffA); PG8_STAGE(PG8_SA(0, 1), cA + hstepA, voffA);
    if (wr == 1) PG8_BAR;
    PG8_WAIT_V(2); PG8_BAR;
    PG8_STAGE1(PG8_SB(1, 0), cB, voffB); PG8_STAGE1(PG8_SB(1, 1), cB + hstepB, voffB);
    PG8_WAIT_V(4); PG8_BAR;
    for (;;) {
        const bool has_next = S.next(ui + 1, nxt);
        const char* nA = has_next ? S.a_ptr(nxt) : cA; const char* nB = has_next ? S.b_ptr(nxt) : cB;
#define PG8_K2(Z) { \
            const bool last = (t == ntc - 2); \
            const char* a0 = cA + (size_t)t * kstep;                                                    \
            const char* a2 = last ? nA : cA + (size_t)(t + 2) * kstep; const char* b2 = last ? nB : cB + (size_t)(t + 2) * kstep; \
              \
            PG8_STAGE1(PG8_SA(1, 0), a0, voffA); PG8_STAGE1(PG8_SA(1, 1), a0 + hstepA, voffA); PG8_SCHED; PG8_LDB(B0, 0, 0); PG8_LDB(B1, 0, 1); PG8_SCHED; PG8_LDA(At, 0, 0); \
            PG8_WAIT_V(8); PG8_WAIT_L(0); PG8_BAR; PG8_MMA(0, 0, At, B0, Z); PG8_MMA(0, 1, At, B1, Z); PG8_BAR; PG8_SCHED; \
              \
            PG8_STAGE(PG8_SB(0, 0), b2, voffB); PG8_STAGE(PG8_SB(0, 1), b2 + hstepB, voffB); PG8_SCHED; PG8_LDA(At, 0, 1); \
            PG8_WAIT_V(4); PG8_WAIT_L(0); PG8_BAR; PG8_MMA(1, 0, At, B0, Z); PG8_MMA(1, 1, At, B1, Z); PG8_BAR; PG8_SCHED; \
              \
            PG8_STAGE(PG8_SA(0, 0), a2, voffA); PG8_STAGE(PG8_SA(0, 1), a2 + hstepA, voffA); PG8_SCHED; PG8_LDB(B0, 1, 0); PG8_LDB(B1, 1, 1); PG8_SCHED; PG8_LDA(At, 1, 0); \
            PG8_WAIT_V(8); PG8_WAIT_L(0); PG8_BAR; PG8_MMA(0, 0, At, B0, false); PG8_MMA(0, 1, At, B1, false); PG8_BAR; PG8_SCHED; \
              \
            PG8_STAGE1(PG8_SB(1, 0), b2, voffB); PG8_STAGE1(PG8_SB(1, 1), b2 + hstepB, voffB); PG8_SCHED; PG8_LDA(At, 1, 1); \
            PG8_WAIT_V(4); PG8_WAIT_L(0); PG8_BAR; PG8_MMA(1, 0, At, B0, false); PG8_MMA(1, 1, At, B1, false); PG8_BAR; PG8_SCHED; }
        { const int t = 0; PG8_K2(true) }
        for (int t = 2; t < ntc; t += 2) PG8_K2(false)
#undef PG8_K2
        if constexpr (Epi::LDSRS && (!FP8 || Epi::RSGATE)) { if (has_next) PG8_RS_ISSUE(nxt.pm); }
        if (wr == 0) PG8_BAR;
        E(acc, cur, wr, wc, fr, fq, rsl + (ui & 1) * 256);
        if constexpr (Epi::LDSRS && FP8 && !Epi::RSGATE) { if (has_next) PG8_RS_ISSUE(nxt.pm); }
        if constexpr (Epi::LDSRS) { if (has_next) PG8_RS_COMMIT((ui + 1) & 1); }
        if (!has_next) break;
        cur = nxt; cA = nA; cB = nB; ++ui; ntc = S.unit_nt(cur, nt);
        if (wr == 1) PG8_BAR;
    }
    PG8_WAIT_V(0);
    PG8_BAR;
#undef PG8_SA
#undef PG8_SB
#undef PG8_STAGE
#undef PG8_STAGE1
#undef PG8_LDA
#undef PG8_LDB
#undef PG8_MMA
#undef PG8_WAIT_V
#undef PG8_WAIT_L
#undef PG8_BAR
#undef PG8_SCHED
#undef PG8_RS_ISSUE
#undef PG8_RS_COMMIT
}

__device__ __forceinline__ f32x4 ps_load(const float* ps, int row, int fq) { return *(const f32x4*)(ps + ((size_t)fq * M + row) * 4); }
__device__ __forceinline__ float ps_rstd(const f32x4 p) {
    float s = (p.x + p.y) + (p.z + p.w);
    s += shx(s, 16); s += shx(s, 32);
    return __builtin_amdgcn_rsqf(s * (1.0f / D) + NORM_EPS);
}
__device__ __forceinline__ void ps_rstd8(const float* ps, int row0, int fq, float (&rs)[8]) {
    f32x4 p[8];
#pragma unroll
    for (int g = 0; g < 8; ++g) p[g] = ps_load(ps, row0 + (g >> 2) * HALF + (g & 3) * 16, fq);
#pragma unroll
    for (int g = 0; g < 8; ++g) rs[g] = ps_rstd(p[g]);
}
template <int ACT> struct EpiBf16 {
    static constexpr bool PERM = true, LDSRS = true, RSGATE = false; static constexpr int MXSH = 0;
    bf16* O; int ldc; int act_pn; const float* ps;
    __device__ __forceinline__ void operator()(const Acc& acc, const Unit& u, int wr, int wc, int fr, int fq, const LAS float* rsl) const {
        const int row0 = u.pm * BM + wr * 64 + fr; const int col0 = u.pn * BM + wc * 32 + 8 * fq;
        const bool act = (ACT == 1) && (u.pn < act_pn);
        float rs8[8];
#pragma unroll
        for (int g = 0; g < 8; ++g) rs8[g] = rsl[wr * 64 + fr + (g >> 2) * HALF + (g & 3) * 16];
#pragma unroll
        for (int ai = 0; ai < 2; ++ai)
#pragma unroll
            for (int m = 0; m < 4; ++m) { bf16* rowp = O + (size_t)(row0 + ai * HALF + m * 16) * ldc + col0;
                const float rs = rs8[ai * 4 + m];
#pragma unroll
                for (int bj = 0; bj < 2; ++bj) { f32x4 v0 = acc[ai][bj][m][0] * rs, v1 = acc[ai][bj][m][1] * rs;
                    if (act) {
#pragma unroll
                        for (int q = 0; q < 4; ++q) { v0[q] = gelu_tanh(v0[q]); v1[q] = gelu_tanh(v1[q]); } }
                    u32x4 w; w.x = cvt_pk_bf16(v0[0], v0[1]); w.y = cvt_pk_bf16(v0[2], v0[3]); w.z = cvt_pk_bf16(v1[0], v1[1]); w.w = cvt_pk_bf16(v1[2], v1[3]);
                    *(u32x4*)(rowp + bj * HALF) = w; }
                asm volatile("" ::: "memory"); }
    }
};
struct EpiF8 {
    static constexpr bool PERM = true, LDSRS = false, RSGATE = false; static constexpr int MXSH = 0;
    unsigned char* O; int ldc;
    __device__ __forceinline__ void operator()(const Acc& acc, const Unit& u, int wr, int wc, int fr, int fq, const LAS float* rsl) const {
        const int row0 = u.pm * BM + wr * 64 + fr; const int col0 = u.pn * BM + wc * 32 + 8 * fq;
#pragma unroll
        for (int ai = 0; ai < 2; ++ai)
#pragma unroll
            for (int m = 0; m < 4; ++m) { unsigned char* rowp = O + (size_t)(unsigned)((row0 + ai * HALF + m * 16) * ldc + col0);
#pragma unroll
                for (int bj = 0; bj < 2; ++bj) { const f32x4 v0 = acc[ai][bj][m][0], v1 = acc[ai][bj][m][1];
                    u32x2 w; w.x = pk4_fp8(v0[0], v0[1], v0[2], v0[3]); w.y = pk4_fp8(v1[0], v1[1], v1[2], v1[3]); *(u32x2*)(rowp + bj * HALF) = w; } }
    }
};
struct EpiSwiglu {
    static constexpr bool PERM = true, LDSRS = false, RSGATE = false; static constexpr int MXSH = 0;
    bf16* O; int ldc; const float* ps;
    __device__ __forceinline__ void operator()(const Acc& acc, const Unit& u, int wr, int wc, int fr, int fq, const LAS float* rsl) const {
        const int row0 = u.pm * BM + wr * 64 + fr; const int col0 = u.pn * HALF + wc * 32 + 8 * fq;
        float rs8[8];
        if (ps) ps_rstd8(ps, row0, fq, rs8); else {
#pragma unroll
            for (int g = 0; g < 8; ++g) rs8[g] = 1.0f; }
#pragma unroll
        for (int ai = 0; ai < 2; ++ai)
#pragma unroll
            for (int m = 0; m < 4; ++m) { bf16* rowp = O + (size_t)(row0 + ai * HALF + m * 16) * ldc + col0;
                const float rs = rs8[ai * 4 + m];
                const f32x4 g0 = acc[ai][0][m][0] * rs, g1 = acc[ai][0][m][1] * rs, u0 = acc[ai][1][m][0] * rs, u1 = acc[ai][1][m][1] * rs;
                float o[8];
#pragma unroll
                for (int q = 0; q < 4; ++q) { o[q] = siluf_(g0[q]) * u0[q]; o[4 + q] = siluf_(g1[q]) * u1[q]; }
                u32x4 w; w.x = cvt_pk_bf16(o[0], o[1]); w.y = cvt_pk_bf16(o[2], o[3]); w.z = cvt_pk_bf16(o[4], o[5]); w.w = cvt_pk_bf16(o[6], o[7]);
                *(u32x4*)rowp = w; asm volatile("" ::: "memory"); }
    }
};
template <int SHU, bool HASPS> struct EpiSwigluF8 {
    static constexpr bool PERM = true, LDSRS = HASPS, RSGATE = false; static constexpr int MXSH = SHU;
    unsigned char* O; int ldc; const float* ps;
    __device__ __forceinline__ void operator()(const Acc& acc, const Unit& u, int wr, int wc, int fr, int fq, const LAS float* rsl) const {
        const int row0 = u.pm * BM + wr * 64 + fr; const int col0 = u.pn * HALF + wc * 32 + 8 * fq;
#pragma unroll
        for (int ai = 0; ai < 2; ++ai) {
            float rs4[4];
            if constexpr (HASPS) {
#pragma unroll
                for (int m = 0; m < 4; ++m) rs4[m] = rsl[wr * 64 + fr + ai * HALF + m * 16]; }
#pragma unroll
            for (int m = 0; m < 4; ++m) { unsigned char* rowp = O + (size_t)(unsigned)((row0 + ai * HALF + m * 16) * ldc + col0);
                f32x4 g0 = acc[ai][0][m][0], g1 = acc[ai][0][m][1], u0 = acc[ai][1][m][0], u1 = acc[ai][1][m][1];
                if constexpr (HASPS) { const float rs = rs4[m]; g0 = g0 * rs; g1 = g1 * rs; u0 = u0 * rs; u1 = u1 * rs; }
                float o[8];
#pragma unroll
                for (int q = 0; q < 4; ++q) { o[q] = siluf_(g0[q]) * u0[q]; o[4 + q] = siluf_(g1[q]) * u1[q]; }
                u32x2 w; w.x = pk4_fp8(o[0], o[1], o[2], o[3]); w.y = pk4_fp8(o[4], o[5], o[6], o[7]);
                *(u32x2*)rowp = w; asm volatile("" ::: "memory"); } }
    }
};
template <int XBF, int SH> struct EpiResBf16 {
    static constexpr bool PERM = true, LDSRS = false, RSGATE = false; static constexpr int MXSH = SH;
    bf16* X; unsigned char* x8; float* ps;
    __device__ __forceinline__ void operator()(const Acc& acc, const Unit& u, int wr, int wc, int fr, int fq, const LAS float* rsl) const {
        const int row0 = u.pm * BM + wr * 64 + fr, col0 = u.pn * BM + wc * 32 + 8 * fq;
#pragma unroll
        for (int ai = 0; ai < 2; ++ai)
#pragma unroll
            for (int m = 0; m < 4; ++m) { const int row = row0 + ai * HALF + m * 16; const unsigned off = (unsigned)(row * D + col0);
                u32x4 r[2];
#pragma unroll
                for (int bj = 0; bj < 2; ++bj) r[bj] = *(const u32x4*)(X + off + bj * HALF);
                float ss = 0.f;
#pragma unroll
                for (int bj = 0; bj < 2; ++bj) {
                    const f32x4 v0 = (f32x4){bflo(r[bj].x), bfhi(r[bj].x), bflo(r[bj].y), bfhi(r[bj].y)} + acc[ai][bj][m][0];
                    const f32x4 v1 = (f32x4){bflo(r[bj].z), bfhi(r[bj].z), bflo(r[bj].w), bfhi(r[bj].w)} + acc[ai][bj][m][1];
                    u32x4 w; w.x = cvt_pk_bf16(v0.x, v0.y); w.y = cvt_pk_bf16(v0.z, v0.w); w.z = cvt_pk_bf16(v1.x, v1.y); w.w = cvt_pk_bf16(v1.z, v1.w);
                    *(u32x4*)(X + off + bj * HALF) = w;
                    if constexpr (XBF == 2) { u32x2 w8; w8.x = pk4_fp8(v0.x, v0.y, v0.z, v0.w); w8.y = pk4_fp8(v1.x, v1.y, v1.z, v1.w); *(u32x2*)(x8 + off + bj * HALF) = w8; }
                    ss += ((v0.x * v0.x + v0.y * v0.y) + (v0.z * v0.z + v0.w * v0.w)) + ((v1.x * v1.x + v1.y * v1.y) + (v1.z * v1.z + v1.w * v1.w)); }
                if (ps) { ss += shx(ss, 16); ss += shx(ss, 32); if (fq == 0) ps[((size_t)u.pn * M + row) * 4 + wc] = ss; }
                asm volatile("" ::: "memory"); }
    }
};
struct EpiMoeDown {
    static constexpr bool PERM = true, LDSRS = true, RSGATE = true; static constexpr int MXSH = WDN_SH;
    bf16* out; float* part; const float* rowg;
    __device__ __forceinline__ void operator()(const Acc& acc, const Unit& u, int wr, int wc, int fr, int fq, const LAS float* rsl) const {
        const int row0 = u.pm * BM + wr * 64 + fr, col0 = u.pn * BM + wc * 32 + 8 * fq;
#pragma unroll
        for (int ai = 0; ai < 2; ++ai)
#pragma unroll
            for (int m = 0; m < 4; ++m) { const int row = row0 + ai * HALF + m * 16; const float g = rsl[wr * 64 + fr + ai * HALF + m * 16];
                if (u.ks < 0) { bf16* rowp = out + (size_t)(unsigned)(row * D + col0);
#pragma unroll
                    for (int bj = 0; bj < 2; ++bj) { const f32x4 v0 = acc[ai][bj][m][0] * g, v1 = acc[ai][bj][m][1] * g;
                        u32x4 w; w.x = cvt_pk_bf16(v0[0], v0[1]); w.y = cvt_pk_bf16(v0[2], v0[3]); w.z = cvt_pk_bf16(v1[0], v1[1]); w.w = cvt_pk_bf16(v1[2], v1[3]);
                        *(u32x4*)(rowp + bj * HALF) = w; } }
                else { float* rowp = part + (size_t)(unsigned)((u.ks * DTAILROWS + (row - DTAILROW0)) * D + col0);
#pragma unroll
                    for (int bj = 0; bj < 2; ++bj) { *(f32x4*)(rowp + bj * HALF) = acc[ai][bj][m][0] * g; *(f32x4*)(rowp + bj * HALF + 4) = acc[ai][bj][m][1] * g; } } }
    }
};
}

struct Args { const float* in[25]; float* out; unsigned char* ws; int ph_lo, ph_hi; };
enum { I_X = 0, I_NMIX, I_NFFN, I_HYWIN, I_QGAIN, I_KGAIN, I_SINKS, I_HYCONV, I_HYWOUT, I_RGWIN, I_RGCONVW, I_RGCONVB, I_GAW, I_GAB, I_GXW, I_GXB, I_LAM, I_RGWOUT,
       I_FFNG, I_FFNU, I_FFND, I_ROUTER, I_MOEG, I_MOEU, I_MOED };

__device__ __forceinline__ void cvt_item(const float* W, int N, bf16* WT, int ldk, int k0, int n0, int drow0, const float* kscale, LAS unsigned* scr, int lane) {
    const int lg = lane & 15, kq = lane >> 4;
    const float* src = W + (size_t)(k0 + 2 * kq) * N + n0 + 4 * lg;
    f32x4 v0[8], v1[8];
#pragma unroll
    for (int s = 0; s < 8; ++s) { v0[s] = *(const f32x4*)(src + (size_t)(8 * s) * N); v1[s] = *(const f32x4*)(src + (size_t)(8 * s + 1) * N); }
    if (kscale) {
#pragma unroll
        for (int s = 0; s < 8; ++s) { const float g0 = kscale[k0 + 2 * kq + 8 * s], g1 = kscale[k0 + 2 * kq + 8 * s + 1]; v0[s] = v0[s] * g0; v1[s] = v1[s] * g1; } }
    const int swz = 4 * (lg & 7);
#pragma unroll
    for (int s = 0; s < 8; ++s) { const int kp = 4 * s + kq;
#pragma unroll
        for (int i = 0; i < 4; ++i) scr[(4 * lg + i) * 32 + (kp ^ swz)] = cvt_pk_bf16(v0[s][i], v1[s][i]); }
    LDS_WAIT(); asm volatile("" ::: "memory");
    const int c = lane & 7;
#pragma unroll
    for (int j = 0; j < 8; ++j) { const int n = 8 * j + (lane >> 3);
        const u32x4 o = *(const LAS u32x4*)(scr + n * 32 + 4 * (c ^ ((n >> 2) & 7)));
        *(u32x4*)(WT + (size_t)(drow0 + n) * ldk + k0 + 8 * c) = o; }
    LDS_WAIT(); asm volatile("" ::: "memory");
}
template <int MODE>
__device__ __forceinline__ void cvt_class(const float* src, int K, int N, int nmat, bf16* dst, size_t dst_stride, const float* kscale, int kstride, int gw, int NGW, LAS unsigned* scr, int lane, int& base) {
    const int nkb = K / 64, nnb = N / 64, per = nkb * nnb, total = per * nmat;
    int first = gw - base % NGW; if (first < 0) first += NGW; base += total;
    for (int it = first; it < total; it += NGW) {
        const int mat = it / per, r = it - mat * per, kb = r / nnb, nb = r - kb * nnb, n0 = nb * 64;
        const int drow0 = (MODE == 0) ? n0 : (256 * (n0 >> 7) + (n0 & 127) + (MODE == 2 ? 128 : 0));
        cvt_item(src + (size_t)mat * K * N, N, dst + (size_t)mat * dst_stride, K, kb * 64, n0, drow0, kscale ? kscale + mat * kstride : nullptr, scr, lane);
    }
}

__device__ __forceinline__ void cvt_item_f8(const float* W, int N, unsigned char* WT, int ldk, int k0, int n0, int drow0, float scale, const float* kscale, LAS unsigned* scr, int lane) {
    const int lg = lane & 15, kq = lane >> 4;
    const float* src = W + (size_t)(k0 + 4 * kq) * N + n0 + 4 * lg;
    f32x4 v[4][4];
#pragma unroll
    for (int s = 0; s < 4; ++s)
#pragma unroll
        for (int j = 0; j < 4; ++j) v[s][j] = *(const f32x4*)(src + (size_t)(16 * s + j) * N);
    float sc[4][4];
#pragma unroll
    for (int s = 0; s < 4; ++s)
#pragma unroll
        for (int j = 0; j < 4; ++j) sc[s][j] = kscale ? scale * kscale[k0 + 4 * kq + 16 * s + j] : scale;
#pragma unroll
    for (int s = 0; s < 4; ++s)
#pragma unroll
        for (int i = 0; i < 4; ++i) scr[(4 * lg + i) * 16 + 4 * (s ^ (lg & 3)) + kq] = pk4_fp8(v[s][0][i] * sc[s][0], v[s][1][i] * sc[s][1], v[s][2][i] * sc[s][2], v[s][3][i] * sc[s][3]);
    LDS_WAIT(); asm volatile("" ::: "memory");
    const int c = lane & 3;
#pragma unroll
    for (int j = 0; j < 4; ++j) { const int n = 16 * j + (lane >> 2);
        const u32x4 o = *(const LAS u32x4*)(scr + n * 16 + 4 * (c ^ ((n >> 2) & 3)));
        *(u32x4*)(WT + (size_t)(drow0 + n) * ldk + k0 + 16 * c) = o; }
    LDS_WAIT(); asm volatile("" ::: "memory");
}
template <int MODE>
__device__ __forceinline__ void cvt_class_f8(const float* src, int K, int N, int nmat, unsigned char* dst, size_t dst_stride, float scale, const float* kscale, int gw, int NGW, LAS unsigned* scr, int lane, int& base, int r_lo = 0, int r_hi = 1 << 30) {
    const int nkb = K / 64, nnb = N / 64, perm = nkb * nnb, r0 = r_lo, per = (r_hi < perm ? r_hi : perm) - r0, total = per * nmat;
    int first = gw - base % NGW; if (first < 0) first += NGW; base += total;
    for (int it = first; it < total; it += NGW) {
        const int mat = it / per, r = r0 + it - mat * per, kb = r / nnb, nb = r - kb * nnb, n0 = nb * 64;
        const int drow0 = (MODE == 0) ? n0 : (256 * (n0 >> 7) + (n0 & 127) + (MODE == 2 ? 128 : 0));
        cvt_item_f8(src + (size_t)mat * K * N, N, dst + (size_t)mat * dst_stride, K, kb * 64, n0, drow0, scale, kscale, scr, lane);
    }
}

__device__ __forceinline__ void norm_store(const f32x4 (&v)[4], const float* gain, bf16* orow, int lane) {
    float ss = 0.f;
#pragma unroll
    for (int j = 0; j < 4; ++j) ss += (v[j].x * v[j].x + v[j].y * v[j].y) + (v[j].z * v[j].z + v[j].w * v[j].w);
    const float rstd = 1.0f / sqrtf(wave_sum(ss) * (1.0f / D) + NORM_EPS);
#pragma unroll
    for (int j = 0; j < 4; ++j) { const f32x4 g = *(const f32x4*)(gain + 256 * j + 4 * lane); const f32x4 o = v[j] * rstd * g;
        u32x2 w; w.x = cvt_pk_bf16(o.x, o.y); w.y = cvt_pk_bf16(o.z, o.w); *(u32x2*)(orow + 256 * j + 4 * lane) = w; }
}
__device__ __forceinline__ void xb_store(const f32x4 (&v)[4], bf16* orow, float* PS, int m, int lane) {
    float ss = 0.f;
#pragma unroll
    for (int j = 0; j < 4; ++j) { ss += (v[j].x * v[j].x + v[j].y * v[j].y) + (v[j].z * v[j].z + v[j].w * v[j].w);
        u32x2 w; w.x = cvt_pk_bf16(v[j].x, v[j].y); w.y = cvt_pk_bf16(v[j].z, v[j].w); *(u32x2*)(orow + 256 * j + 4 * lane) = w; }
    ss = wave_sum(ss);
    if (lane < 16) PS[((size_t)(lane >> 2) * M + m) * 4 + (lane & 3)] = (lane == 0) ? ss : 0.f;
}
__device__ __forceinline__ void phase_xb(const float* X, bf16* XB, float* PS, int gw, int NGW, int lane) {
    for (int m = gw; m < M; m += NGW) { const f32x4* xr = (const f32x4*)(X + (size_t)m * D) + lane; f32x4 v[4];
#pragma unroll
        for (int j = 0; j < 4; ++j) v[j] = xr[64 * j];
        xb_store(v, XB + (size_t)m * D, PS, m, lane); }
}
__device__ __forceinline__ void norm_store_f8(const f32x4 (&v)[4], const float* gain, unsigned char* orow, int lane) {
    float ss = 0.f;
#pragma unroll
    for (int j = 0; j < 4; ++j) ss += (v[j].x * v[j].x + v[j].y * v[j].y) + (v[j].z * v[j].z + v[j].w * v[j].w);
    const float rstd = 1.0f / sqrtf(wave_sum(ss) * (1.0f / D) + NORM_EPS);
#pragma unroll
    for (int j = 0; j < 4; ++j) { const f32x4 g = *(const f32x4*)(gain + 256 * j + 4 * lane); const f32x4 o = v[j] * rstd * g;
        *(unsigned*)(orow + 256 * j + 4 * lane) = pk4_fp8(o.x, o.y, o.z, o.w); }
}
__device__ __forceinline__ void phase_norm_f8(const float* X, const float* gain, unsigned char* H, int gw, int NGW, int lane) {
    for (int m = gw; m < M; m += NGW) { const f32x4* xr = (const f32x4*)(X + (size_t)m * D) + lane; f32x4 v[4];
#pragma unroll
        for (int j = 0; j < 4; ++j) v[j] = xr[64 * j];
        norm_store_f8(v, gain, H + (size_t)m * D, lane); }
}
__device__ __forceinline__ void phase_norm(const float* X, const float* gain, bf16* H, int gw, int NGW, int lane) {
    for (int m = gw; m < M; m += NGW) { const f32x4* xr = (const f32x4*)(X + (size_t)m * D) + lane; f32x4 v[4];
#pragma unroll
        for (int j = 0; j < 4; ++j) v[j] = xr[64 * j];
        norm_store(v, gain, H + (size_t)m * D, lane); }
}

constexpr int KS_LD = 72, VT_LD = 264;
constexpr int ATT_KS = 0, ATT_VT = 256 * KS_LD * 2;
__device__ __forceinline__ void attn_unit(LAS unsigned char* lds, const bf16* P, bf16* MIX, const float* qg, const float* kg, const float* sinks, int b, int n, int kh, int wv) {
    const int tid = tid_laundered(wv), lane = tid & 63, wave = tid >> 6, fr = lane & 15, fq = lane >> 4;
    LAS bf16* Ks = (LAS bf16*)(lds + ATT_KS); LAS bf16* Vt = (LAS bf16*)(lds + ATT_VT);
    const int rowb = b * SEQ + (n - 1) * 128;
    { const int dch = tid & 7;
      float kgv[8];
#pragma unroll
      for (int j = 0; j < 8; ++j) kgv[j] = kg[8 * dch + j];
#pragma unroll
      for (int p = 0; p < 4; ++p) { const int key = p * 64 + (tid >> 3); const bool ok = (n > 0) || (key >= 128);
        u32x4 kw = (u32x4){0u, 0u, 0u, 0u}, vw = (u32x4){0u, 0u, 0u, 0u};
        if (ok) { const bf16* rp = P + (size_t)(rowb + key) * EIN; kw = *(const u32x4*)(rp + 512 + kh * 64 + 8 * dch); vw = *(const u32x4*)(rp + 640 + kh * 64 + 8 * dch); }
        float kf[8] = {bflo(kw.x), bfhi(kw.x), bflo(kw.y), bfhi(kw.y), bflo(kw.z), bfhi(kw.z), bflo(kw.w), bfhi(kw.w)};
        float ss = 0.f;
#pragma unroll
        for (int j = 0; j < 8; ++j) ss += kf[j] * kf[j];
        ss += shx(ss, 1); ss += shx(ss, 2); ss += shx(ss, 4);
        const float rstd = 1.0f / sqrtf(ss * (1.0f / 64.0f) + NORM_EPS);
        u32x4 ko; ko.x = cvt_pk_bf16(kf[0] * rstd * kgv[0], kf[1] * rstd * kgv[1]); ko.y = cvt_pk_bf16(kf[2] * rstd * kgv[2], kf[3] * rstd * kgv[3]);
        ko.z = cvt_pk_bf16(kf[4] * rstd * kgv[4], kf[5] * rstd * kgv[5]); ko.w = cvt_pk_bf16(kf[6] * rstd * kgv[6], kf[7] * rstd * kgv[7]);
        *(LAS u32x4*)(Ks + key * KS_LD + 8 * dch) = ko;
        const unsigned vv[4] = {vw.x, vw.y, vw.z, vw.w};
#pragma unroll
        for (int j = 0; j < 4; ++j) { Vt[(8 * dch + 2 * j) * VT_LD + key] = (bf16)(vv[j] & 0xffffu); Vt[(8 * dch + 2 * j + 1) * VT_LD + key] = (bf16)(vv[j] >> 16); }
      } }
    const int g = wave >> 1, qh = wave & 1, hq = kh * 4 + g;
    bf16x8 Qf[4][2];
    { float qgv[2][8];
#pragma unroll
      for (int s = 0; s < 2; ++s)
#pragma unroll
          for (int j = 0; j < 8; ++j) qgv[s][j] = qg[32 * s + 8 * fq + j] * 0.125f;
#pragma unroll
      for (int qt = 0; qt < 4; ++qt) { const int row = b * SEQ + n * 128 + 64 * qh + 16 * qt + fr; const bf16* rp = P + (size_t)row * EIN + hq * 64 + 8 * fq;
        const u32x4 w0 = *(const u32x4*)rp, w1 = *(const u32x4*)(rp + 32);
        float q0[8] = {bflo(w0.x), bfhi(w0.x), bflo(w0.y), bfhi(w0.y), bflo(w0.z), bfhi(w0.z), bflo(w0.w), bfhi(w0.w)};
        float q1[8] = {bflo(w1.x), bfhi(w1.x), bflo(w1.y), bfhi(w1.y), bflo(w1.z), bfhi(w1.z), bflo(w1.w), bfhi(w1.w)};
        float ss = 0.f;
#pragma unroll
        for (int j = 0; j < 8; ++j) ss += q0[j] * q0[j] + q1[j] * q1[j];
        ss += shx(ss, 16); ss += shx(ss, 32);
        const float rstd = 1.0f / sqrtf(ss * (1.0f / 64.0f) + NORM_EPS);
        u32x4 a, c;
        a.x = cvt_pk_bf16(q0[0] * rstd * qgv[0][0], q0[1] * rstd * qgv[0][1]); a.y = cvt_pk_bf16(q0[2] * rstd * qgv[0][2], q0[3] * rstd * qgv[0][3]);
        a.z = cvt_pk_bf16(q0[4] * rstd * qgv[0][4], q0[5] * rstd * qgv[0][5]); a.w = cvt_pk_bf16(q0[6] * rstd * qgv[0][6], q0[7] * rstd * qgv[0][7]);
        c.x = cvt_pk_bf16(q1[0] * rstd * qgv[1][0], q1[1] * rstd * qgv[1][1]); c.y = cvt_pk_bf16(q1[2] * rstd * qgv[1][2], q1[3] * rstd * qgv[1][3]);
        c.z = cvt_pk_bf16(q1[4] * rstd * qgv[1][4], q1[5] * rstd * qgv[1][5]); c.w = cvt_pk_bf16(q1[6] * rstd * qgv[1][6], q1[7] * rstd * qgv[1][7]);
        Qf[qt][0] = __builtin_bit_cast(bf16x8, a); Qf[qt][1] = __builtin_bit_cast(bf16x8, c); } }
    __syncthreads();
    const float slope = exp2f(-(float)(hq + 1)); const float sink = sinks[hq];
#pragma unroll
    for (int qt = 0; qt < 4; ++qt) {
        const int tq0 = 64 * qh + 16 * qt; const int kt0 = (tq0 >> 4) < 6 ? (tq0 >> 4) : 6;
        f32x4 S[10];
#pragma unroll
        for (int kk = 0; kk < 10; ++kk) { S[kk] = (f32x4){0.f, 0.f, 0.f, 0.f};
#pragma unroll
            for (int s = 0; s < 2; ++s) { const bf16x8 Kf = *(const LAS bf16x8*)(Ks + (16 * (kt0 + kk) + fr) * KS_LD + 32 * s + 8 * fq);
                S[kk] = __builtin_amdgcn_mfma_f32_16x16x32_bf16(Kf, Qf[qt][s], S[kk], 0, 0, 0); } }
        const int tqq = tq0 + fr; float mx = sink;
#pragma unroll
        for (int kk = 0; kk < 10; ++kk)
#pragma unroll
            for (int i = 0; i < 4; ++i) { const int sb = 16 * (kt0 + kk) + 4 * fq + i; const int diff = 128 + tqq - sb;
                const bool valid = (diff >= 0) && (diff < 128) && ((n > 0) || (sb >= 128));
                const float v = valid ? (S[kk][i] - slope * (float)diff) : -1e30f; S[kk][i] = v; mx = fmaxf(mx, v); }
        mx = fmaxf(mx, shx(mx, 16)); mx = fmaxf(mx, shx(mx, 32));
        float l = 0.f;
#pragma unroll
        for (int kk = 0; kk < 10; ++kk)
#pragma unroll
            for (int i = 0; i < 4; ++i) { const float p = fast_exp(S[kk][i] - mx); S[kk][i] = p; l += p; }
        l += shx(l, 16); l += shx(l, 32);
        l += fast_exp(sink - mx);
        const float inv = 1.0f / l;
        f32x4 O[4];
#pragma unroll
        for (int dt = 0; dt < 4; ++dt) O[dt] = (f32x4){0.f, 0.f, 0.f, 0.f};
#pragma unroll
        for (int pp = 0; pp < 5; ++pp) { u32x4 pw; pw.x = cvt_pk_bf16(S[2 * pp][0], S[2 * pp][1]); pw.y = cvt_pk_bf16(S[2 * pp][2], S[2 * pp][3]);
            pw.z = cvt_pk_bf16(S[2 * pp + 1][0], S[2 * pp + 1][1]); pw.w = cvt_pk_bf16(S[2 * pp + 1][2], S[2 * pp + 1][3]);
            const bf16x8 Pf = __builtin_bit_cast(bf16x8, pw);
#pragma unroll
            for (int dt = 0; dt < 4; ++dt) { const LAS bf16* vp = Vt + (16 * dt + fr) * VT_LD + 16 * (kt0 + 2 * pp) + 4 * fq;
                const u32x2 va = *(const LAS u32x2*)vp, vb = *(const LAS u32x2*)(vp + 16);
                u32x4 vw; vw.x = va.x; vw.y = va.y; vw.z = vb.x; vw.w = vb.y;
                O[dt] = __builtin_amdgcn_mfma_f32_16x16x32_bf16(__builtin_bit_cast(bf16x8, vw), Pf, O[dt], 0, 0, 0); } }
        bf16* op = MIX + (size_t)(b * SEQ + n * 128 + tqq) * D + hq * 64 + 4 * fq;
#pragma unroll
        for (int dt = 0; dt < 4; ++dt) { u32x2 w; w.x = cvt_pk_bf16(O[dt][0] * inv, O[dt][1] * inv); w.y = cvt_pk_bf16(O[dt][2] * inv, O[dt][3] * inv); *(u32x2*)(op + 16 * dt) = w; }
    }
    __syncthreads();
}
__device__ __forceinline__ void phase_attn_conv(LAS unsigned char* lds, const bf16* P, bf16* MIX, const float* qg, const float* kg, const float* sinks, const float* convw, int bid, int G, int wv) {
    for (int u = bid; u < BATCH * 16 * 2; u += G) { const int kh = u & 1, n = (u >> 1) & 15, b = u >> 5; attn_unit(lds, P, MIX, qg, kg, sinks, b, n, kh, wv); }
    const int tid = tid_laundered(wv), cg = tid & 63, rsub = tid >> 6, c0 = 8 * cg;
    float w[3][8];
#pragma unroll
    for (int k = 0; k < 3; ++k)
#pragma unroll
        for (int i = 0; i < 8; ++i) w[k][i] = convw[k * 512 + c0 + i];
    for (int r64 = bid; r64 < M / 64; r64 += G) { const int row0 = r64 * 64 + rsub * 8, t0 = row0 & (SEQ - 1);
        u32x4 gc[10], uu[10], gb[8];
#pragma unroll
        for (int j = 0; j < 10; ++j) { gc[j] = (u32x4){0u, 0u, 0u, 0u}; uu[j] = (u32x4){0u, 0u, 0u, 0u};
            if (t0 - 2 + j >= 0) { const bf16* rp = P + (size_t)(row0 - 2 + j) * EIN; gc[j] = *(const u32x4*)(rp + 1280 + c0); uu[j] = *(const u32x4*)(rp + 1792 + c0); } }
#pragma unroll
        for (int r = 0; r < 8; ++r) gb[r] = *(const u32x4*)(P + (size_t)(row0 + r) * EIN + 768 + c0);
#pragma unroll
        for (int r = 0; r < 8; ++r) { float acc[8];
#pragma unroll
            for (int i = 0; i < 8; ++i) acc[i] = 0.f;
#pragma unroll
            for (int k = 0; k < 3; ++k) { const unsigned gw_[4] = {gc[r + k].x, gc[r + k].y, gc[r + k].z, gc[r + k].w}, uw[4] = {uu[r + k].x, uu[r + k].y, uu[r + k].z, uu[r + k].w};
#pragma unroll
                for (int q = 0; q < 4; ++q) { acc[2 * q] += w[k][2 * q] * (bflo(gw_[q]) * bflo(uw[q])); acc[2 * q + 1] += w[k][2 * q + 1] * (bfhi(gw_[q]) * bfhi(uw[q])); } }
            const unsigned gbw[4] = {gb[r].x, gb[r].y, gb[r].z, gb[r].w}; u32x4 o; unsigned ow[4];
#pragma unroll
            for (int q = 0; q < 4; ++q) ow[q] = cvt_pk_bf16(bflo(gbw[q]) * acc[2 * q], bfhi(gbw[q]) * acc[2 * q + 1]);
            o.x = ow[0]; o.y = ow[1]; o.z = ow[2]; o.w = ow[3];
            *(u32x4*)(MIX + (size_t)(row0 + r) * D + 512 + c0) = o; } }
}

__device__ __forceinline__ void phase_conv4(const bf16* P, bf16* XC, const float* cw, const float* cb, int bid, int G, int wv) {
    const int tid = tid_laundered(wv), cg = tid & 127, rsub = tid >> 7, c0 = 8 * cg;
    float w[4][8], bias[8];
#pragma unroll
    for (int k = 0; k < 4; ++k)
#pragma unroll
        for (int i = 0; i < 8; ++i) w[k][i] = cw[k * D + c0 + i];
#pragma unroll
    for (int i = 0; i < 8; ++i) bias[i] = cb[c0 + i];
    for (int r32 = bid; r32 < M / 32; r32 += G) { const int row0 = r32 * 32 + rsub * 8, t0 = row0 & (SEQ - 1);
        u32x4 xv[11];
#pragma unroll
        for (int j = 0; j < 11; ++j) { xv[j] = (u32x4){0u, 0u, 0u, 0u}; if (t0 - 3 + j >= 0) xv[j] = *(const u32x4*)(P + (size_t)(row0 - 3 + j) * 2048 + 1024 + c0); }
#pragma unroll
        for (int r = 0; r < 8; ++r) { float acc[8];
#pragma unroll
            for (int i = 0; i < 8; ++i) acc[i] = bias[i];
#pragma unroll
            for (int k = 0; k < 4; ++k) { const unsigned xw[4] = {xv[r + k].x, xv[r + k].y, xv[r + k].z, xv[r + k].w};
#pragma unroll
                for (int j = 0; j < 4; ++j) { acc[2 * j] += w[k][2 * j] * bflo(xw[j]); acc[2 * j + 1] += w[k][2 * j + 1] * bfhi(xw[j]); } }
            u32x4 o; o.x = cvt_pk_bf16(acc[0], acc[1]); o.y = cvt_pk_bf16(acc[2], acc[3]); o.z = cvt_pk_bf16(acc[4], acc[5]); o.w = cvt_pk_bf16(acc[6], acc[7]);
            *(u32x4*)(XC + (size_t)(row0 + r) * D + c0) = o; } }
}
__device__ __forceinline__ void conv4_tile(const bf16* P, bf16* XC, const float* cw, const float* cb, int pm, int head, int tid) {
    const int cg = tid & 15, rg = tid >> 4, c0 = 128 * head + 8 * cg, row0 = 256 * pm + 8 * rg, t0 = row0 & (SEQ - 1);
    float w[4][8], bias[8];
#pragma unroll
    for (int k = 0; k < 4; ++k)
#pragma unroll
        for (int i = 0; i < 8; ++i) w[k][i] = cw[k * D + c0 + i];
#pragma unroll
    for (int i = 0; i < 8; ++i) bias[i] = cb[c0 + i];
    u32x4 xv[11];
#pragma unroll
    for (int j = 0; j < 11; ++j) { xv[j] = (u32x4){0u, 0u, 0u, 0u}; if (t0 - 3 + j >= 0) xv[j] = *(const u32x4*)(P + (size_t)(row0 - 3 + j) * 2048 + 1024 + c0); }
#pragma unroll
    for (int r = 0; r < 8; ++r) { float acc[8];
#pragma unroll
        for (int i = 0; i < 8; ++i) acc[i] = bias[i];
#pragma unroll
        for (int k = 0; k < 4; ++k) { const unsigned xw[4] = {xv[r + k].x, xv[r + k].y, xv[r + k].z, xv[r + k].w};
#pragma unroll
            for (int j = 0; j < 4; ++j) { acc[2 * j] += w[k][2 * j] * bflo(xw[j]); acc[2 * j + 1] += w[k][2 * j + 1] * bfhi(xw[j]); } }
        u32x4 o; o.x = cvt_pk_bf16(acc[0], acc[1]); o.y = cvt_pk_bf16(acc[2], acc[3]); o.z = cvt_pk_bf16(acc[4], acc[5]); o.w = cvt_pk_bf16(acc[6], acc[7]);
        *(u32x4*)(XC + (size_t)(row0 + r) * D + c0) = o; }
}
struct LruConst { f32x2 ba, bx, sp8; };
__device__ __forceinline__ LruConst lru_const(const float* ga_b, const float* gx_b, const float* lam, int c) {
    LruConst k; k.ba = *(const f32x2*)(ga_b + c); k.bx = *(const f32x2*)(gx_b + c); const f32x2 l = *(const f32x2*)(lam + c);
    const float z0 = -l.x, z1 = -l.y;
    k.sp8.x = 8.0f * ((z0 > 0.f ? z0 : 0.f) + log1pf(__expf(-fabsf(z0)))); k.sp8.y = 8.0f * ((z1 > 0.f ? z1 : 0.f) + log1pf(__expf(-fabsf(z1)))); return k;
}
__device__ __forceinline__ float one_minus_exp(float x) {
    const float s = -x * (1.0f + x * 0.5f * (1.0f + x * (1.0f / 3.0f) * (1.0f + x * 0.25f * (1.0f + x * 0.2f))));
    return x > -0.1f ? s : 1.0f - __expf(x);
}
__device__ __forceinline__ void lru_ab_f(const LruConst& k, f32x2 ga, f32x2 gx, f32x2 xc, bool first, f32x2& a, f32x2& b) {
    const float r0 = sigmoidf_(ga.x + k.ba.x), r1 = sigmoidf_(ga.y + k.ba.y), i0 = sigmoidf_(gx.x + k.bx.x), i1 = sigmoidf_(gx.y + k.bx.y);
    const float la0 = -r0 * k.sp8.x, la1 = -r1 * k.sp8.y;
    a.x = fast_exp(la0); a.y = fast_exp(la1);
    float m0 = __builtin_amdgcn_sqrtf(fmaxf(__builtin_fmaf(-a.x, a.x, 1.0f), 0.f)), m1 = __builtin_amdgcn_sqrtf(fmaxf(__builtin_fmaf(-a.y, a.y, 1.0f), 0.f));
    if (first) { m0 = 1.0f; m1 = 1.0f; }
    b.x = m0 * (i0 * xc.x); b.y = m1 * (i1 * xc.y);
}
__device__ __forceinline__ void lru_ab4(const LruConst& k0, const LruConst& k1, unsigned gaw, unsigned gxw, u32x2 xcw, bool first, f32x4& a, f32x4& b) {
    const f32x2 ga0 = __builtin_amdgcn_cvt_pk_f32_fp8(gaw, false), ga1 = __builtin_amdgcn_cvt_pk_f32_fp8(gaw, true), gx0 = __builtin_amdgcn_cvt_pk_f32_fp8(gxw, false), gx1 = __builtin_amdgcn_cvt_pk_f32_fp8(gxw, true);
    f32x2 a0, b0, a1, b1;
    lru_ab_f(k0, ga0, gx0, (f32x2){bflo(xcw.x), bfhi(xcw.x)}, first, a0, b0);
    lru_ab_f(k1, ga1, gx1, (f32x2){bflo(xcw.y), bfhi(xcw.y)}, first, a1, b1);
    a = (f32x4){a0.x, a0.y, a1.x, a1.y}; b = (f32x4){b0.x, b0.y, b1.x, b1.y};
}
__device__ __forceinline__ void phase_scan1(const unsigned char* GT, const bf16* XC, const float* ga_b, const float* gx_b, const float* lam, float* CARA, float* CARH, int bid, int G, int wv) {
    const int tid = tid_laundered(wv), sub = tid >> 8, c = 4 * (tid & 255); const int gcol = 256 * (c >> 7) + (c & 127);
    const LruConst k0 = lru_const(ga_b, gx_b, lam, c), k1 = lru_const(ga_b, gx_b, lam, c + 2);
    for (int it = 2 * bid + sub; it < BATCH * NSCH; it += 2 * G) { const int b = it / NSCH, ch = it % NSCH; const size_t row0 = (size_t)(b * SEQ + ch * SCH);
        f32x4 ap = (f32x4){1.f, 1.f, 1.f, 1.f}, h = (f32x4){0.f, 0.f, 0.f, 0.f};
#pragma unroll 8
        for (int t = 0; t < SCH; ++t) { const size_t r = row0 + t; const unsigned gaw = *(const unsigned*)(GT + r * 2048 + gcol), gxw = *(const unsigned*)(GT + r * 2048 + gcol + 128); const u32x2 xcw = *(const u32x2*)(XC + r * D + c);
            f32x4 a, bb; lru_ab4(k0, k1, gaw, gxw, xcw, (ch == 0) && (t == 0), a, bb); h = a * h + bb; ap = ap * a; }
        *(f32x4*)(CARA + (size_t)it * D + c) = ap; *(f32x4*)(CARH + (size_t)it * D + c) = h; }
}
__device__ __forceinline__ void phase_scan2(const unsigned char* GT, const bf16* XC, const float* ga_b, const float* gx_b, const float* lam, const float* CARA, const float* CARH, const bf16* P, bf16* MIX, int bid, int G, int wv) {
    const int tid = tid_laundered(wv), sub = tid >> 8, c = 4 * (tid & 255); const int gcol = 256 * (c >> 7) + (c & 127);
    const LruConst k0 = lru_const(ga_b, gx_b, lam, c), k1 = lru_const(ga_b, gx_b, lam, c + 2);
    for (int it = 2 * bid + sub; it < BATCH * NSCH; it += 2 * G) { const int b = it / NSCH, ch = it % NSCH; const size_t row0 = (size_t)(b * SEQ + ch * SCH);
        f32x4 h = (f32x4){0.f, 0.f, 0.f, 0.f};
#pragma unroll 4
        for (int kk = 0; kk < ch; ++kk) { const f32x4 a = *(const f32x4*)(CARA + (size_t)(b * NSCH + kk) * D + c), hh = *(const f32x4*)(CARH + (size_t)(b * NSCH + kk) * D + c); h = a * h + hh; }
#pragma unroll 8
        for (int t = 0; t < SCH; ++t) { const size_t r = row0 + t; const unsigned gaw = *(const unsigned*)(GT + r * 2048 + gcol), gxw = *(const unsigned*)(GT + r * 2048 + gcol + 128); const u32x2 xcw = *(const u32x2*)(XC + r * D + c);
            f32x4 a, bb; lru_ab4(k0, k1, gaw, gxw, xcw, (ch == 0) && (t == 0), a, bb); h = a * h + bb;
            const u32x2 yw = *(const u32x2*)(P + r * 2048 + c); u32x2 o;
            o.x = cvt_pk_bf16(bflo(yw.x) * h.x, bfhi(yw.x) * h.y); o.y = cvt_pk_bf16(bflo(yw.y) * h.z, bfhi(yw.y) * h.w);
            *(u32x2*)(MIX + r * D + c) = o; } }
}
__device__ __forceinline__ void phase_router(LAS unsigned char* lds, const bf16* X, const float* gain, const float* wr, bf16* H, int* SELP, float* GATE2, int* CC, int bid, int G, int wv) {
    const int tid = tid_laundered(wv), lane = tid & 63, wave = tid >> 6;
    LAS float* wrt = (LAS float*)lds;
    LAS int* sel_e = (LAS int*)(lds + 32768); LAS float* sel_g = (LAS float*)(lds + 32768 + 512);
    for (int idx = tid; idx < 8192; idx += NTHR) { const int c = idx >> 3, e = idx & 7; wrt[e * 1024 + c] = wr[idx]; }
    __syncthreads();
    for (int chunk = bid; chunk < M / 64; chunk += G) {
        for (int i = 0; i < 8; ++i) { const int r = wave * 8 + i, m = chunk * 64 + r;
            const u32x2* xr = (const u32x2*)(X + (size_t)m * D) + lane; f32x4 v[4]; float ss = 0.f;
#pragma unroll
            for (int j = 0; j < 4; ++j) { const u32x2 w = xr[64 * j]; v[j] = (f32x4){bflo(w.x), bfhi(w.x), bflo(w.y), bfhi(w.y)}; ss += (v[j].x * v[j].x + v[j].y * v[j].y) + (v[j].z * v[j].z + v[j].w * v[j].w); }
            const float rstd = 1.0f / sqrtf(wave_sum(ss) * (1.0f / D) + NORM_EPS);
#pragma unroll
            for (int j = 0; j < 4; ++j) { const f32x4 g = *(const f32x4*)(gain + 256 * j + 4 * lane); v[j] = v[j] * rstd * g;
                *(unsigned*)((unsigned char*)H + (size_t)m * D + 256 * j + 4 * lane) = pk4_fp8(v[j].x, v[j].y, v[j].z, v[j].w); }
            float lg[8];
#pragma unroll
            for (int e = 0; e < 8; ++e) { float s = 0.f;
#pragma unroll
                for (int j = 0; j < 4; ++j) { const f32x4 w = *(const LAS f32x4*)(wrt + e * 1024 + 256 * j + 4 * lane); s += (v[j].x * w.x + v[j].y * w.y) + (v[j].z * w.z + v[j].w * w.w); }
                lg[e] = wave_sum(s); }
            int e1 = 0; float l1 = lg[0];
#pragma unroll
            for (int e = 1; e < 8; ++e) if (lg[e] > l1) { l1 = lg[e]; e1 = e; }
            int e2 = (e1 == 0) ? 1 : 0; float l2 = (e1 == 0) ? lg[1] : lg[0];
#pragma unroll
            for (int e = 1; e < 8; ++e) if (e != e1 && lg[e] > l2) { l2 = lg[e]; e2 = e; }
            const float g1 = 1.0f / (1.0f + __expf(l2 - l1)), g2 = 1.0f - g1;
            if (lane == 0) { sel_e[2 * r] = e1; sel_e[2 * r + 1] = e2; sel_g[2 * r] = g1; sel_g[2 * r + 1] = g2; }
        }
        __syncthreads();
        if (wave == 0) { const int ea = sel_e[2 * lane], eb = sel_e[2 * lane + 1]; int pa = 0, pb = 0; const unsigned long long lt = (1ull << lane) - 1ull;
#pragma unroll
            for (int e = 0; e < 8; ++e) { const unsigned long long ma = __ballot(ea == e), mb = __ballot(eb == e); const int ca = __popcll(ma), cb = __popcll(mb);
                if (ea == e) pa = __popcll(ma & lt);
                if (eb == e) pb = ca + __popcll(mb & lt);
                if (lane == e) CC[chunk * 32 + e] = ca + cb; }
            const int tok = chunk * 64 + lane;
            SELP[tok] = ea | (eb << 4) | (pa << 8) | (pb << 16);
            *(f32x2*)(GATE2 + 2 * tok) = (f32x2){sel_g[2 * lane], sel_g[2 * lane + 1]}; }
        __syncthreads();
    }
}
__device__ __forceinline__ void expert_offsets(unsigned* cnt, int (&c)[8], int (&off)[9]) {
    int o = 0;
#pragma unroll
    for (int e = 0; e < 8; ++e) { c[e] = (int)__hip_atomic_load(cnt + e * 64, RLX_AGENT); off[e] = o; o += (c[e] + 255) & ~255; }
    off[8] = o;
}
__device__ __forceinline__ void phase_gather(LAS unsigned char* lds, unsigned* cnt, const int* SELP, const float* GATE2, const int* CC, const bf16* H, unsigned char* HG, float* ROWG, int* CSLOT, int bid, int gw, int NGW, int wv) {
    const int tid = tid_laundered(wv), lane = tid & 63, wave = tid >> 6;
    LAS int* pre = (LAS int*)lds;
    LAS int* tot = (LAS int*)(lds + 8192);
    {
        const int e = wave; int v[4], s = 0;
#pragma unroll
        for (int q = 0; q < 4; ++q) { v[q] = CC[(4 * lane + q) * 32 + e]; s += v[q]; }
        int inc = s;
#pragma unroll
        for (int o = 1; o < 64; o <<= 1) { const int t = shup(inc, o); if (lane >= o) inc += t; }
        int ex = inc - s;
#pragma unroll
        for (int q = 0; q < 4; ++q) { pre[(4 * lane + q) * 8 + e] = ex; ex += v[q]; }
        if (lane == 63) tot[e] = inc;
    }
    __syncthreads();
    int c[8], off[9]; { int o = 0;
#pragma unroll
        for (int e = 0; e < 8; ++e) { c[e] = tot[e]; off[e] = o; o += (c[e] + 255) & ~255; }
        off[8] = o; }
    if (bid == 0 && tid < 8) __hip_atomic_store(cnt + tid * 64, (unsigned)tot[tid], RLX_AGENT);
    for (int m = gw; m < M; m += NGW) { const int sp = SELP[m]; const int ch = m >> 6; const f32x2 g2 = *(const f32x2*)(GATE2 + 2 * m);
        const u32x4 o = ((const u32x4*)((const unsigned char*)H + (size_t)m * D))[lane];
#pragma unroll
        for (int k = 0; k < 2; ++k) { const int e = (sp >> (4 * k)) & 15, rk = (sp >> (8 + 8 * k)) & 255;
            int oe = 0;
#pragma unroll
            for (int q = 0; q < 8; ++q) oe = (q == e) ? off[q] : oe;
            const int r = oe + pre[ch * 8 + e] + rk;
            ((u32x4*)(HG + (size_t)r * D))[lane] = o;
            if (lane == 0) { ROWG[r] = k ? g2.y : g2.x; CSLOT[2 * m + k] = r; } } }
    for (int e = 0; e < 8; ++e) { const int r0 = off[e] + c[e], r1 = off[e + 1];
        for (int r = r0 + gw; r < r1; r += NGW) { ((u32x4*)(HG + (size_t)r * D))[lane] = (u32x4){0u, 0u, 0u, 0u}; if (lane == 0) ROWG[r] = 0.f; } }
}
__device__ __forceinline__ f32x4 moe_row4(const bf16* YB, const float* PART, int s, bool split, int col) {
    if (split && s >= DTAILROW0) { const float* p = PART + (size_t)(s - DTAILROW0) * D + col; f32x4 a = *(const f32x4*)p;
#pragma unroll 1
        for (int k = 1; k < DSPL; ++k) { a = a + *(const f32x4*)(p + (size_t)k * DTAILROWS * D); asm volatile("" : "+v"(a)); }
        return a; }
    const u32x2 w = *(const u32x2*)(YB + (size_t)s * D + col); return (f32x4){bflo(w.x), bfhi(w.x), bflo(w.y), bfhi(w.y)};
}
__device__ __forceinline__ void phase_combine(bf16* X, float* OUT, const bf16* YB, const float* PART, const int* CSLOT, unsigned* cnt, float* PS, bool last, int gw, int NGW, int G, int lane) {
    int c[8], off[9]; expert_offsets(cnt, c, off); const int NP = off[8] / 256; const bool split = (G == 256) && NP >= 128 && NP <= 137;
    for (int m = gw; m < M; m += NGW) { const int s0 = CSLOT[2 * m], s1 = CSLOT[2 * m + 1];
        const u32x2* xr = (const u32x2*)(X + (size_t)m * D) + lane; f32x4 v[4];
#pragma unroll
        for (int j = 0; j < 4; ++j) { const u32x2 w = xr[64 * j]; const f32x4 x = (f32x4){bflo(w.x), bfhi(w.x), bflo(w.y), bfhi(w.y)};
            v[j] = (x + moe_row4(YB, PART, s0, split, 256 * j + 4 * lane)) + moe_row4(YB, PART, s1, split, 256 * j + 4 * lane); }
        if (last) {
#pragma unroll
            for (int j = 0; j < 4; ++j) ((f32x4*)(OUT + (size_t)m * D) + lane)[64 * j] = v[j]; }
        else xb_store(v, X + (size_t)m * D, PS, m, lane); }
}

__device__ __forceinline__ int ph_lo_() { const __attribute__((address_space(4))) Args* a = (const __attribute__((address_space(4))) Args*)__builtin_amdgcn_kernarg_segment_ptr(); asm volatile("" : "+s"(a)); return a->ph_lo; }
__device__ __forceinline__ int ph_hi_() { const __attribute__((address_space(4))) Args* a = (const __attribute__((address_space(4))) Args*)__builtin_amdgcn_kernarg_segment_ptr(); asm volatile("" : "+s"(a)); return a->ph_hi; }
constexpr int NPH_PER = 18, NPHASES = 1 + 2 * NPH_PER;
#define PH_BEGIN() const __attribute__((address_space(4))) Args* ap = (const __attribute__((address_space(4))) Args*)__builtin_amdgcn_kernarg_segment_ptr(); asm volatile("" : "+s"(ap)); unsigned char* const ws = ap->ws; (void)ws; const int G = (int)gridDim.x, bid = (int)blockIdx.x; (void)G; (void)bid
#if MK_PER_PHASE
#define GRID_BAR() do { } while (0)
#else
#define GRID_BAR() do { PH_BEGIN(); XcdBarrier b_; b_.bar = (unsigned*)(ws + WS_CTL) + CW_BAR; b_.x = xb_xcc_id(); b_.st = (volatile LAS unsigned*)(lds + MISC_OFF) + 8; xcd_barrier(b_, tid_laundered(wv) == 0); } while (0)
#endif
#if MK_PER_PHASE
#define IN(k) (ph_lo_() <= (k) && (k) < ph_hi_())
#else
#define IN(k) true
#endif
#define SEAM(k) do { if (IN(k) && IN((k) + 1)) GRID_BAR(); } while (0)
#define WAVE_IDS() const int wave = wv_laundered(wv); const int tidl = tid_laundered(wave); const int lane = tidl & 63; const int gw = bid * NWAVES + wave, NGW = G * NWAVES; (void)lane; (void)gw; (void)NGW
template <int jj>
__device__ __forceinline__ void layer_pair(LAS unsigned char* lds, const int wv) {
        const int pb = 1 + NPH_PER * jj;
        REP(0) {
        if (IN(pb + 0)) {
            PH_BEGIN();
            pg8::StaticOrder S; S.init(M / 256, EIN / 256, G, bid, ws + WS_X, (size_t)256 * D * 2, 0, ws + WS_WINE + (size_t)jj * EIN * D * 2, (size_t)256 * D * 2);
            pg8::EpiBf16<0> E{(bf16*)(ws + WS_P), EIN, 0, (const float*)(ws + WS_PS)};
            pg8::gemm_phase<false>(lds, wv, 2 * D, 2 * D, 2 * D, S, E);
            if (G == 256 && bid >= 64) {
                const int wave = wv_laundered(wv), lane = tid_laundered(wave) & 63; LAS unsigned* scr = (LAS unsigned*)(lds + wave * 8192);
                const int gw2 = (bid - 64) * NWAVES + wave, NGW2 = 192 * NWAVES; int cbase2 = 0;
                cvt_class_f8<1>(ap->in[I_MOEG] + (size_t)jj * 8 * D * FF, D, FF, 8, ws + WS_WGUM + (size_t)jj * 8 * 2 * FF * D, (size_t)2 * FF * D, WGU_SCALE, nullptr, gw2, NGW2, scr, lane, cbase2, MOE_DEFER_R0);
                cvt_class_f8<2>(ap->in[I_MOEU] + (size_t)jj * 8 * D * FF, D, FF, 8, ws + WS_WGUM + (size_t)jj * 8 * 2 * FF * D, (size_t)2 * FF * D, WGU_SCALE, nullptr, gw2, NGW2, scr, lane, cbase2, MOE_DEFER_R0);
            }
        }
        SEAM(pb + 0);
        }
        REP(1) {
        if (IN(pb + 1)) { PH_BEGIN();
            phase_attn_conv(lds, (const bf16*)(ws + WS_P), (bf16*)(ws + WS_MIX), ap->in[I_QGAIN] + jj * 64, ap->in[I_KGAIN] + jj * 64, ap->in[I_SINKS] + jj * 8, ap->in[I_HYCONV] + jj * 3 * 512, bid, G, wv); }
        SEAM(pb + 1);
        }
        REP(2) {
        if (IN(pb + 2)) {
            PH_BEGIN();
            pg8::StaticOrder S; S.init(M / 256, D / 256, G, bid, ws + WS_MIX, (size_t)256 * D * 2, 0, ws + WS_WOUTE + (size_t)jj * D * D * 2, (size_t)256 * D * 2);
            pg8::EpiResBf16<FFN_F8(jj) ? 2 : 0, 0> E{(bf16*)(ws + WS_X), ws + WS_H, (float*)(ws + WS_PS)};
            pg8::gemm_phase<false>(lds, wv, 2 * D, 2 * D, 2 * D, S, E);
        }
        SEAM(pb + 2);
        }
        REP(4) {
        if (IN(pb + 4)) {
            PH_BEGIN();
            if constexpr (FFN_F8(jj)) {
            pg8::StaticOrder S; S.init(M / 256, 2 * FF / 256, G, bid, ws + WS_H, (size_t)256 * D, 0, ws + WS_WGU + (size_t)jj * 2 * FF * D * 2, (size_t)256 * D);
            pg8::EpiSwigluF8<WGU_SH, true> E{ws + WS_HID, FF, (const float*)(ws + WS_PS)};
            pg8::gemm_phase<true>(lds, wv, D, D, D, S, E);
            } else {
            pg8::StaticOrder S; S.init(M / 256, 2 * FF / 256, G, bid, ws + WS_X, (size_t)256 * D * 2, 0, ws + WS_WGU + (size_t)jj * 2 * FF * D * 2, (size_t)256 * D * 2);
            if constexpr (FFN_DN_F8(jj)) { pg8::EpiSwigluF8<0, true> E{ws + WS_HID, FF, (const float*)(ws + WS_PS)}; pg8::gemm_phase<false>(lds, wv, 2 * D, 2 * D, 2 * D, S, E); }
            else { pg8::EpiSwiglu E{(bf16*)(ws + WS_HID), FF, (const float*)(ws + WS_PS)}; pg8::gemm_phase<false>(lds, wv, 2 * D, 2 * D, 2 * D, S, E); }
            }
        }
        SEAM(pb + 4);
        }
        REP(5) {
        if (IN(pb + 5)) {
            PH_BEGIN();
            if constexpr (FFN_F8(jj) || FFN_DN_F8(jj)) {
            pg8::StaticOrder S; S.init(M / 256, D / 256, G, bid, ws + WS_HID, (size_t)256 * FF, 0, ws + WS_WDN + (size_t)jj * D * FF * 2, (size_t)256 * FF);
            pg8::EpiResBf16<0, WDN_SH> E{(bf16*)(ws + WS_X), nullptr, (float*)(ws + WS_PS)};
            pg8::gemm_phase<true>(lds, wv, FF, FF, FF, S, E);
            } else {
            pg8::StaticOrder S; S.init(M / 256, D / 256, G, bid, ws + WS_HID, (size_t)256 * FF * 2, 0, ws + WS_WDN + (size_t)jj * D * FF * 2, (size_t)256 * FF * 2);
            pg8::EpiResBf16<0, 0> E{(bf16*)(ws + WS_X), nullptr, (float*)(ws + WS_PS)};
            pg8::gemm_phase<false>(lds, wv, 2 * FF, 2 * FF, 2 * FF, S, E);
            }
        }
        SEAM(pb + 5);
        }
        REP(7) {
        if (IN(pb + 7)) {
            PH_BEGIN();
            pg8::StaticOrder S; S.init(M / 256, 2 * D / 256, G, bid, ws + WS_X, (size_t)256 * D * 2, 0, ws + WS_WINO + (size_t)jj * 2 * D * D * 2, (size_t)256 * D * 2);
            pg8::EpiBf16<1> E{(bf16*)(ws + WS_P), 2 * D, 4, (const float*)(ws + WS_PS)};
            pg8::gemm_phase<false>(lds, wv, 2 * D, 2 * D, 2 * D, S, E);
        }
        SEAM(pb + 7);
        }
        REP(9) {
        if (IN(pb + 9)) {
            PH_BEGIN();
            pg8::StaticOrder S; S.init(M / 256, 8, G, bid, ws + WS_XC, (size_t)256 * D * 2, (size_t)128 * 2, ws + WS_WG + (size_t)jj * 8 * 256 * 128 * 2, (size_t)256 * 128 * 2);
            pg8::EpiF8 E{ws + WS_GT, 2 * D};
            {
                const int tid_c = tid_laundered(wv); pg8::Unit uc;
                for (int i = 0; S.next(i, uc); ++i) conv4_tile((const bf16*)(ws + WS_P), (bf16*)(ws + WS_XC), ap->in[I_RGCONVW] + jj * 4 * D, ap->in[I_RGCONVB] + jj * D, uc.pm, uc.pn, tid_c);
                asm volatile("s_waitcnt vmcnt(0)" ::: "memory"); __syncthreads(); }
            pg8::gemm_phase<false>(lds, wv, 2 * D, 2 * 128, 2 * 128, S, E);
        }
        SEAM(pb + 9);
        }
        REP(10) {
        if (IN(pb + 10)) { PH_BEGIN(); phase_scan1(ws + WS_GT, (const bf16*)(ws + WS_XC), ap->in[I_GAB] + jj * D, ap->in[I_GXB] + jj * D, ap->in[I_LAM] + jj * D, (float*)(ws + WS_CARA), (float*)(ws + WS_CARH), bid, G, wv); }
        SEAM(pb + 10);
        }
        REP(11) {
        if (IN(pb + 11)) { PH_BEGIN(); phase_scan2(ws + WS_GT, (const bf16*)(ws + WS_XC), ap->in[I_GAB] + jj * D, ap->in[I_GXB] + jj * D, ap->in[I_LAM] + jj * D, (const float*)(ws + WS_CARA), (const float*)(ws + WS_CARH), (const bf16*)(ws + WS_P), (bf16*)(ws + WS_MIX), bid, G, wv); }
        SEAM(pb + 11);
        }
        REP(12) {
        if (IN(pb + 12)) {
            PH_BEGIN();
            pg8::StaticOrder S; S.init(M / 256, D / 256, G, bid, ws + WS_MIX, (size_t)256 * D * 2, 0, ws + WS_WOUTO + (size_t)jj * D * D * 2, (size_t)256 * D * 2);
            pg8::EpiResBf16<0, 0> E{(bf16*)(ws + WS_X), nullptr, nullptr};
            pg8::gemm_phase<false>(lds, wv, 2 * D, 2 * D, 2 * D, S, E);
        }
        SEAM(pb + 12);
        }
        REP(13) {
        if (IN(pb + 13)) { PH_BEGIN();
            phase_router(lds, (const bf16*)(ws + WS_X), ap->in[I_NFFN] + (2 * jj + 1) * D, ap->in[I_ROUTER] + jj * D * 8, (bf16*)(ws + WS_H), (int*)(ws + WS_SELP), (float*)(ws + WS_GATE2), (int*)(ws + WS_CC), bid, G, wv); }
        SEAM(pb + 13);
        }
        REP(14) {
        if (IN(pb + 14)) { PH_BEGIN(); WAVE_IDS();
            phase_gather(lds, (unsigned*)(ws + WS_CTL) + CW_CNT + jj * 8 * 64, (const int*)(ws + WS_SELP), (const float*)(ws + WS_GATE2), (const int*)(ws + WS_CC), (const bf16*)(ws + WS_H), ws + WS_HG, (float*)(ws + WS_ROWG), (int*)(ws + WS_CSLOT), bid, gw, NGW, wv); }
        SEAM(pb + 14);
        }
        REP(15) {
        if (IN(pb + 15)) {
            PH_BEGIN();
            int c[8], off[9]; expert_offsets((unsigned*)(ws + WS_CTL) + CW_CNT + jj * 8 * 64, c, off);
            pg8::GroupOrder S; S.nM = __builtin_amdgcn_readfirstlane(off[8] / 256); S.nN = 2 * FF / 256; S.nwg = S.nM * S.nN; S.G = G; S.c = bid;
#pragma unroll
            for (int e = 0; e < 8; ++e) S.cum[e] = __builtin_amdgcn_readfirstlane(off[e + 1] / 256);
            S.A = (const char*)(ws + WS_HG); S.a_pm = (size_t)256 * D; S.B = (const char*)(ws + WS_WGUM + (size_t)jj * 8 * 2 * FF * D); S.b_pn = (size_t)256 * D; S.b_e = (size_t)2 * FF * D;
            pg8::EpiSwigluF8<WGU_SH, false> E{ws + WS_HID, FF, nullptr};
            pg8::gemm_phase<true>(lds, wv, D, D, D, S, E);
        }
        SEAM(pb + 15);
        }
        REP(16) {
        if (IN(pb + 16)) {
            PH_BEGIN();
            int c[8], off[9]; expert_offsets((unsigned*)(ws + WS_CTL) + CW_CNT + jj * 8 * 64, c, off);
            pg8::DownOrder S; S.NP = __builtin_amdgcn_readfirstlane(off[8] / 256); S.G = G; S.c = bid;
            S.split = (G == 256) && S.NP >= 128 && S.NP <= 137; S.TU = (S.NP - 128) * 4;
#pragma unroll
            for (int e = 0; e < 8; ++e) S.cum[e] = __builtin_amdgcn_readfirstlane(off[e + 1] / 256);
            S.A = (const char*)(ws + WS_HID); S.a_pm = (size_t)256 * FF; S.B = (const char*)(ws + WS_WDNM + (size_t)jj * 8 * D * FF); S.b_pn = (size_t)256 * FF; S.b_e = (size_t)D * FF;
            pg8::EpiMoeDown E{(bf16*)(ws + WS_YB), (float*)(ws + WS_PART), (const float*)(ws + WS_ROWG)};
            pg8::gemm_phase<true>(lds, wv, FF, FF, FF, S, E);
        }
        SEAM(pb + 16);
        }
        REP(17) {
        if (IN(pb + 17)) { PH_BEGIN(); WAVE_IDS();
            phase_combine((bf16*)(ws + WS_X), ap->out, (const bf16*)(ws + WS_YB), (const float*)(ws + WS_PART), (const int*)(ws + WS_CSLOT), (unsigned*)(ws + WS_CTL) + CW_CNT + jj * 8 * 64, (float*)(ws + WS_PS), jj == 1, gw, NGW, G, lane); }
        if (jj == 0) SEAM(pb + 17);
        }
}
__global__ void __launch_bounds__(NTHR, 2) mega_fwd(Args args) {
    extern __shared__ __attribute__((aligned(16))) unsigned char lds_raw[];
    LAS unsigned char* lds = (LAS unsigned char*)lds_raw;
    const int tid = threadIdx.x; const int wv = __builtin_amdgcn_readfirstlane(tid >> 6);
    for (int u = tid; u < (LDS_BYTES - LDSCTL_OFF) / 4; u += NTHR) ((LAS unsigned*)(lds + LDSCTL_OFF))[u] = 0u;
    __syncthreads();
#if !MK_PER_PHASE
    (void)xcd_barrier_post((unsigned*)(args.ws + WS_CTL) + CW_BAR, (volatile LAS unsigned*)(lds + MISC_OFF) + 8, tid == 0);
#endif

    REP(18) {
    if (IN(0)) {
        PH_BEGIN(); WAVE_IDS();
        LAS unsigned* scr = (LAS unsigned*)(lds + wave * 8192); int cbase = 0;
        cvt_class<0>(ap->in[I_HYWIN], D, EIN, 2, (bf16*)(ws + WS_WINE), (size_t)EIN * D, ap->in[I_NMIX], 2 * D, gw, NGW, scr, lane, cbase);
        cvt_class<0>(ap->in[I_HYWOUT], D, D, 2, (bf16*)(ws + WS_WOUTE), (size_t)D * D, nullptr, 0, gw, NGW, scr, lane, cbase);
        cvt_class<0>(ap->in[I_RGWIN], D, 2 * D, 2, (bf16*)(ws + WS_WINO), (size_t)2 * D * D, ap->in[I_NMIX] + D, 2 * D, gw, NGW, scr, lane, cbase);
        cvt_class<0>(ap->in[I_RGWOUT], D, D, 2, (bf16*)(ws + WS_WOUTO), (size_t)D * D, nullptr, 0, gw, NGW, scr, lane, cbase);
        cvt_class<0>(ap->in[I_GAW], 128, 128, 16, (bf16*)(ws + WS_WG), (size_t)256 * 128, nullptr, 0, gw, NGW, scr, lane, cbase);
        cvt_class<0>(ap->in[I_GXW], 128, 128, 16, (bf16*)(ws + WS_WG) + 128 * 128, (size_t)256 * 128, nullptr, 0, gw, NGW, scr, lane, cbase);
#pragma unroll
        for (int j2 = 0; j2 < 2; ++j2) {
            if (FFN_F8(j2)) {
                cvt_class_f8<1>(ap->in[I_FFNG] + (size_t)j2 * D * FF, D, FF, 1, ws + WS_WGU + (size_t)j2 * 2 * FF * D * 2, 0, WGU_SCALE, ap->in[I_NFFN] + 2 * j2 * D, gw, NGW, scr, lane, cbase);
                cvt_class_f8<2>(ap->in[I_FFNU] + (size_t)j2 * D * FF, D, FF, 1, ws + WS_WGU + (size_t)j2 * 2 * FF * D * 2, 0, WGU_SCALE, ap->in[I_NFFN] + 2 * j2 * D, gw, NGW, scr, lane, cbase);
                cvt_class_f8<0>(ap->in[I_FFND] + (size_t)j2 * D * FF, FF, D, 1, ws + WS_WDN + (size_t)j2 * D * FF * 2, 0, WDN_SCALE, nullptr, gw, NGW, scr, lane, cbase);
            } else {
                cvt_class<1>(ap->in[I_FFNG] + (size_t)j2 * D * FF, D, FF, 1, (bf16*)(ws + WS_WGU) + (size_t)j2 * 2 * FF * D, 0, ap->in[I_NFFN] + 2 * j2 * D, 0, gw, NGW, scr, lane, cbase);
                cvt_class<2>(ap->in[I_FFNU] + (size_t)j2 * D * FF, D, FF, 1, (bf16*)(ws + WS_WGU) + (size_t)j2 * 2 * FF * D, 0, ap->in[I_NFFN] + 2 * j2 * D, 0, gw, NGW, scr, lane, cbase);
                if (FFN_DN_F8(j2)) cvt_class_f8<0>(ap->in[I_FFND] + (size_t)j2 * D * FF, FF, D, 1, ws + WS_WDN + (size_t)j2 * D * FF * 2, 0, WDN_SCALE, nullptr, gw, NGW, scr, lane, cbase);
                else cvt_class<0>(ap->in[I_FFND] + (size_t)j2 * D * FF, FF, D, 1, (bf16*)(ws + WS_WDN) + (size_t)j2 * D * FF, 0, nullptr, 0, gw, NGW, scr, lane, cbase);
            } }
        const int r_hi = (G == 256) ? MOE_DEFER_R0 : (1 << 30);
        cvt_class_f8<1>(ap->in[I_MOEG], D, FF, 16, ws + WS_WGUM, (size_t)2 * FF * D, WGU_SCALE, nullptr, gw, NGW, scr, lane, cbase, 0, r_hi);
        cvt_class_f8<2>(ap->in[I_MOEU], D, FF, 16, ws + WS_WGUM, (size_t)2 * FF * D, WGU_SCALE, nullptr, gw, NGW, scr, lane, cbase, 0, r_hi);
        cvt_class_f8<0>(ap->in[I_MOED], FF, D, 16, ws + WS_WDNM, (size_t)D * FF, WDN_SCALE, nullptr, gw, NGW, scr, lane, cbase);
        phase_xb(ap->in[I_X], (bf16*)(ws + WS_X), (float*)(ws + WS_PS), gw, NGW, lane);
    }
    SEAM(0);
    }

    layer_pair<0>(lds, wv);
    layer_pair<1>(lds, wv);
#undef IN
#undef SEAM
#undef GRID_BAR
#undef WAVE_IDS
}

extern "C" void kernel_launch(void* const* d_in, const int* in_sizes, int n_in, void* d_out, int out_size, void* d_ws, size_t ws_size, hipStream_t stream) {
    static int grid = 0;
    if (grid == 0) {
        if (n_in != 25 || in_sizes[0] != M * D || out_size != M * D || ws_size < WS_END) { fprintf(stderr, "kernel_launch: unexpected shapes (n_in %d, ws %zu)\n", n_in, ws_size); grid = -1; return; }
        int dev = 0, cus = 0, per_cu = 0;
        if (hipGetDevice(&dev) != hipSuccess || hipDeviceGetAttribute(&cus, hipDeviceAttributeMultiprocessorCount, dev) != hipSuccess) { grid = -1; return; }
        if (hipFuncSetAttribute((const void*)mega_fwd, hipFuncAttributeMaxDynamicSharedMemorySize, LDS_BYTES) != hipSuccess) { fprintf(stderr, "kernel_launch: hipFuncSetAttribute failed\n"); grid = -1; return; }
        if (hipOccupancyMaxActiveBlocksPerMultiprocessor(&per_cu, (const void*)mega_fwd, NTHR, LDS_BYTES) != hipSuccess || per_cu < 1) { fprintf(stderr, "kernel_launch: occupancy query says %d\n", per_cu); }
        (void)hipGetLastError();
        grid = cus;
    }
    if (grid < 0) return;
    if (hipMemsetAsync((char*)d_ws + WS_CTL, 0, CTL_ZERO_BYTES, stream) != hipSuccess) return;
    Args a{};
    for (int i = 0; i < 25; ++i) a.in[i] = (const float*)d_in[i];
    a.out = (float*)d_out; a.ws = (unsigned char*)d_ws;
#if MK_PER_PHASE
    for (int p = 0; p < NPHASES; ++p) { a.ph_lo = p; a.ph_hi = p + 1; hipLaunchKernelGGL(mega_fwd, dim3(grid), dim3(NTHR), LDS_BYTES, stream, a); }
#else
    a.ph_lo = 0; a.ph_hi = NPHASES;
    hipLaunchKernelGGL(mega_fwd, dim3(grid), dim3(NTHR), LDS_BYTES, stream, a);
#endif
}
```
